# Optimizing an MI355X kernel written in HIP

```python
import math
import jax, jax.numpy as jnp
from jax import lax
import numpy as np

D_MODEL = 1024
BATCH = 8
SEQ = 2048
DEPTH = 1

N_HEADS = 8
Q_LORA = 256
KV_LORA = 128
QK_NOPE = 64
QK_ROPE = 32
V_HEAD = 64
QK_HEAD = QK_NOPE + QK_ROPE
ATTN_SCALE = 1.0 / math.sqrt(QK_HEAD)
ROPE_THETA = 10000.0
Q_BLOCK = 128
CONV_CH = 512
CONV_K = 31
D_FF = ((8 * D_MODEL // 3 + 255) // 256) * 256
N_BRANCH = 2
D_IN = Q_LORA + KV_LORA + QK_ROPE + 2 * CONV_CH + N_BRANCH * D_MODEL
IN_SPLITS = (Q_LORA, Q_LORA + KV_LORA, Q_LORA + KV_LORA + QK_ROPE,
             Q_LORA + KV_LORA + QK_ROPE + 2 * CONV_CH)
N_MOD = 6
EPS_RMS = 1e-6
EPS_LN = 1e-5

kernel_name = "hybrid_mla_conformer_gated_encoder_block"


def rms_norm(x, g):
    xf = x.astype(jnp.float32)
    y = xf * lax.rsqrt(jnp.mean(xf * xf, axis=-1, keepdims=True) + EPS_RMS)
    return (y * g.astype(jnp.float32)).astype(x.dtype)


def layer_norm(x, g, b):
    xf = x.astype(jnp.float32)
    mu = jnp.mean(xf, axis=-1, keepdims=True)
    var = jnp.mean(jnp.square(xf - mu), axis=-1, keepdims=True)
    y = (xf - mu) * lax.rsqrt(var + EPS_LN)
    return (y * g.astype(jnp.float32) + b.astype(jnp.float32)).astype(x.dtype)


def rope_cos_sin(positions):
    inv_freq = ROPE_THETA ** (-jnp.arange(0, QK_ROPE, 2, dtype=jnp.float32) / QK_ROPE)
    ang = positions.astype(jnp.float32)[..., None] * inv_freq
    return jnp.cos(ang), jnp.sin(ang)


def apply_rope(x, cos, sin):
    shape = cos.shape[:2] + (1,) * (x.ndim - 3) + cos.shape[-1:]
    cos = cos.reshape(shape)
    sin = sin.reshape(shape)
    xf = x.astype(jnp.float32)
    x1, x2 = jnp.split(xf, 2, axis=-1)
    out = jnp.concatenate([x1 * cos - x2 * sin, x2 * cos + x1 * sin], axis=-1)
    return out.astype(x.dtype)


def mla_attention(q_nope, q_rope, k_nope, k_rope, v):
    B, S, H, _ = q_nope.shape
    nb = S // Q_BLOCK
    qn = q_nope.reshape(B, nb, Q_BLOCK, H, QK_NOPE).transpose(1, 0, 2, 3, 4)
    qr = q_rope.reshape(B, nb, Q_BLOCK, H, QK_ROPE).transpose(1, 0, 2, 3, 4)

    def block(args):
        qn_b, qr_b = args
        s = (jnp.einsum('bqhd,bkhd->bhqk', qn_b, k_nope)
             + jnp.einsum('bqhr,bkr->bhqk', qr_b, k_rope))
        p = jax.nn.softmax(s.astype(jnp.float32) * ATTN_SCALE, axis=-1).astype(v.dtype)
        return jnp.einsum('bhqk,bkhd->bqhd', p, v)

    o = lax.map(block, (qn, qr))
    return o.transpose(1, 0, 2, 3, 4).reshape(B, S, H * V_HEAD)


def depthwise_conv(z, w, b):
    out = lax.conv_general_dilated(
        z, w[:, None, :].astype(z.dtype), window_strides=(1,),
        padding=[(CONV_K // 2, CONV_K // 2)],
        dimension_numbers=('NWC', 'WIO', 'NWC'),
        feature_group_count=z.shape[-1])
    return out + b.astype(z.dtype)


def setup_inputs(seed: int = 0) -> dict:
    key = jax.random.key(seed)
    ks = jax.random.split(key, 24)
    f32 = jnp.float32

    def w(k, shape, fan_in, mult=1.0):
        return jax.random.normal(k, shape, f32) * (mult * fan_in ** -0.5)

    def gain(k, shape):
        return 1.0 + 0.02 * jax.random.normal(k, shape, f32)

    x = jax.random.normal(ks[0], (BATCH, SEQ, D_MODEL), f32)
    c = jax.random.normal(ks[1], (BATCH, D_MODEL), f32)
    offsets = jax.random.randint(ks[2], (BATCH, 1), 0, 4096, dtype=jnp.int32)
    positions = (jnp.arange(SEQ, dtype=jnp.int32)[None, :] + offsets).astype(jnp.int32)
    L = DEPTH
    return {
        "x": x,
        "c": c,
        "positions": positions,
        "w_ada": w(ks[3], (L, D_MODEL, N_MOD * D_MODEL), D_MODEL, 0.5),
        "b_ada": 0.02 * jax.random.normal(ks[4], (L, N_MOD * D_MODEL), f32),
        "g_norm_mix": gain(ks[5], (L, D_MODEL)),
        "w_in": w(ks[6], (L, D_MODEL, D_IN), D_MODEL),
        "g_q_a": gain(ks[7], (L, Q_LORA)),
        "w_q_up": w(ks[8], (L, Q_LORA, N_HEADS * QK_HEAD), Q_LORA),
        "g_kv_a": gain(ks[9], (L, KV_LORA)),
        "w_kv_up": w(ks[10], (L, KV_LORA, N_HEADS * (QK_NOPE + V_HEAD)), KV_LORA),
        "w_attn_o": w(ks[11], (L, N_HEADS * V_HEAD, D_MODEL), N_HEADS * V_HEAD),
        "w_dw": w(ks[12], (L, CONV_K, CONV_CH), CONV_K),
        "b_dw": 0.02 * jax.random.normal(ks[13], (L, CONV_CH), f32),
        "g_conv_ln": gain(ks[14], (L, CONV_CH)),
        "b_conv_ln": 0.02 * jax.random.normal(ks[15], (L, CONV_CH), f32),
        "w_conv_out": w(ks[16], (L, CONV_CH, D_MODEL), CONV_CH),
        "w_out": w(ks[17], (L, D_MODEL, D_MODEL), D_MODEL),
        "g_norm_ffn": gain(ks[18], (L, D_MODEL)),
        "w_ffn_gate": w(ks[19], (L, D_MODEL, D_FF), D_MODEL),
        "w_ffn_up": w(ks[20], (L, D_MODEL, D_FF), D_MODEL),
        "w_ffn_down": w(ks[21], (L, D_FF, D_MODEL), D_FF),
        "g_final": gain(ks[22], (D_MODEL,)),
    }


def reference(x, c, positions, w_ada, b_ada, g_norm_mix, w_in, g_q_a, w_q_up, g_kv_a, w_kv_up,
              w_attn_o, w_dw, b_dw, g_conv_ln, b_conv_ln, w_conv_out, w_out, g_norm_ffn,
              w_ffn_gate, w_ffn_up, w_ffn_down, g_final):
    B, S, D = x.shape
    cos, sin = rope_cos_sin(positions)
    c_act = jax.nn.silu(c)

    for l in range(DEPTH):
        mod = c_act @ w_ada[l] + b_ada[l]
        shift_m, scale_m, gate_m, shift_f, scale_f, gate_f = [
            m[:, None, :] for m in jnp.split(mod, N_MOD, axis=-1)]

        h = rms_norm(x, g_norm_mix[l]) * (1.0 + scale_m) + shift_m
        proj = h @ w_in[l]
        q_a, kv_a, k_rope, conv_in, gate_logits = jnp.split(proj, IN_SPLITS, axis=-1)

        q = (rms_norm(q_a, g_q_a[l]) @ w_q_up[l]).reshape(B, S, N_HEADS, QK_HEAD)
        q_nope, q_rope = q[..., :QK_NOPE], apply_rope(q[..., QK_NOPE:], cos, sin)
        kv = (rms_norm(kv_a, g_kv_a[l]) @ w_kv_up[l]).reshape(B, S, N_HEADS, QK_NOPE + V_HEAD)
        k_nope, v = kv[..., :QK_NOPE], kv[..., QK_NOPE:]
        k_rope = apply_rope(k_rope, cos, sin)
        y_a = mla_attention(q_nope, q_rope, k_nope, k_rope, v) @ w_attn_o[l]

        u, u_gate = jnp.split(conv_in, 2, axis=-1)
        z = u * jax.nn.sigmoid(u_gate)
        z = depthwise_conv(z, w_dw[l], b_dw[l])
        z = jax.nn.silu(layer_norm(z, g_conv_ln[l], b_conv_ln[l]))
        y_b = z @ w_conv_out[l]

        g_a, g_b = jnp.split(gate_logits, N_BRANCH, axis=-1)
        merged = jax.nn.sigmoid(g_a) * y_a + jax.nn.sigmoid(g_b) * y_b
        x = x + gate_m * (merged @ w_out[l])

        h2 = rms_norm(x, g_norm_ffn[l]) * (1.0 + scale_f) + shift_f
        ff = (jax.nn.silu(h2 @ w_ffn_gate[l]) * (h2 @ w_ffn_up[l])) @ w_ffn_down[l]
        x = x + gate_f * ff

    return rms_norm(x, g_final)
```

```cpp
#include <hip/hip_runtime.h>
#include <stdint.h>

namespace nv {
constexpr int B = 8, S = 2048, D = 1024, H = 8, QL = 256, KVL = 128, NOPE = 64, ROPE = 32, VH = 64, QKH = 96;
constexpr int CC = 512, CK = 31, DFF = 2816, DIN = 3488, NMOD = 6;
constexpr float ATTN_SCALE = 0.10206207261596577f;

__device__ __forceinline__ float sigmoidf_(float v) { return 1.f / (1.f + __expf(-v)); }
__device__ __forceinline__ float siluf_(float v) { return v / (1.f + __expf(-v)); }

__device__ __forceinline__ float block_sum_256(float v, float* red) {
    for (int o = 32; o > 0; o >>= 1) v += __shfl_xor(v, o);
    const int w = threadIdx.x >> 6;
    __syncthreads();
    if ((threadIdx.x & 63) == 0) red[w] = v;
    __syncthreads();
    return red[0] + red[1] + red[2] + red[3];
}

__global__ void __launch_bounds__(256) k_mod(const float* c, const float* w_ada, const float* b_ada, float* mod) {
    const int j = blockIdx.x * 256 + threadIdx.x, b = blockIdx.y;
    float acc = b_ada[j];
    for (int k = 0; k < D; ++k) acc += siluf_(c[b * D + k]) * w_ada[(size_t)k * (NMOD * D) + j];
    mod[b * (NMOD * D) + j] = acc;
}

__global__ void __launch_bounds__(256) k_rms(const float* in, int ld_in, float* out, int ld_out, int n, const float* g, const float* scale, const float* shift, float eps) {
    __shared__ float red[4];
    const float* r = in + (size_t)blockIdx.x * ld_in; float* o = out + (size_t)blockIdx.x * ld_out;
    float s = 0.f;
    for (int i = threadIdx.x; i < n; i += 256) { const float v = r[i]; s += v * v; }
    s = block_sum_256(s, red);
    const float rstd = rsqrtf(s / (float)n + eps);
    for (int i = threadIdx.x; i < n; i += 256) { float v = r[i] * rstd * g[i]; if (scale) v = v * (1.f + scale[i]) + shift[i]; o[i] = v; }
}

template <int EPI>
__global__ void __launch_bounds__(256) k_gemm(const float* A, int lda, const float* Bm, int ldb, float* C, int ldc, int M, int N, int K, const float* R, int ldr, const float* gate) {
    __shared__ float As[16][65];
    __shared__ float Bs[16][65];
    const int tx = threadIdx.x & 15, ty = threadIdx.x >> 4;
    const int m0 = blockIdx.y * 64, n0 = blockIdx.x * 64;
    float acc[4][4];
    for (int i = 0; i < 4; ++i) for (int j = 0; j < 4; ++j) acc[i][j] = 0.f;
    for (int k0 = 0; k0 < K; k0 += 16) {
        for (int e = threadIdx.x; e < 64 * 16; e += 256) {
            const int mm = e >> 4, kk = e & 15;
            As[kk][mm] = (m0 + mm < M) ? A[(size_t)(m0 + mm) * lda + k0 + kk] : 0.f;
        }
        for (int e = threadIdx.x; e < 64 * 16; e += 256) {
            const int kk = e >> 6, nn = e & 63;
            Bs[kk][nn] = (n0 + nn < N) ? Bm[(size_t)(k0 + kk) * ldb + n0 + nn] : 0.f;
        }
        __syncthreads();
#pragma unroll
        for (int kk = 0; kk < 16; ++kk) {
            float a[4], b[4];
#pragma unroll
            for (int i = 0; i < 4; ++i) a[i] = As[kk][ty * 4 + i];
#pragma unroll
            for (int j = 0; j < 4; ++j) b[j] = Bs[kk][tx + 16 * j];
#pragma unroll
            for (int i = 0; i < 4; ++i)
#pragma unroll
                for (int j = 0; j < 4; ++j) acc[i][j] += a[i] * b[j];
        }
        __syncthreads();
    }
    for (int i = 0; i < 4; ++i) {
        const int m = m0 + ty * 4 + i; if (m >= M) continue;
        for (int j = 0; j < 4; ++j) {
            const int n = n0 + tx + 16 * j; if (n >= N) continue;
            float v = acc[i][j];
            if (EPI == 1) v = R[(size_t)m * ldr + n] + gate[n] * v;
            C[(size_t)m * ldc + n] = v;
        }
    }
}

__device__ __forceinline__ void rope_cs(int pos, int i, float& cs, float& sn) {
    const float invf[16] = {1.0f, 0.5623413251903491f, 0.31622776601683794f, 0.1778279410038923f, 0.1f, 0.05623413251903491f, 0.03162277660168379f, 0.01778279410038923f,
                            0.01f, 0.005623413251903491f, 0.0031622776601683794f, 0.0017782794100389228f, 0.001f, 0.0005623413251903491f, 0.00031622776601683794f, 0.00017782794100389227f};
    float f = 1.0f;
#pragma unroll
    for (int q = 0; q < 16; ++q) if (q == i) f = invf[q];
    const float ang = (float)pos * f;
    const double a = (double)ang;
    const double kq = rint(a * 0.15915494309189535);
    const float r = (float)(a - kq * 6.283185307179586);
    cs = cosf(r); sn = sinf(r);
}

__global__ void __launch_bounds__(256) k_rope(float* buf, int ld, int off, int hstride, int nheads, const int* pos, int rows) {
    const int idx = blockIdx.x * 256 + threadIdx.x;
    const int i = idx & 15, hh = (idx >> 4) % nheads, m = (idx >> 4) / nheads;
    if (m >= rows) return;
    float cs, sn; rope_cs(pos[m], i, cs, sn);
    float* p = buf + (size_t)m * ld + off + hh * hstride;
    const float x1 = p[i], x2 = p[i + 16];
    p[i] = x1 * cs - x2 * sn; p[i + 16] = x2 * cs + x1 * sn;
}

__global__ void __launch_bounds__(256) k_attn(const float* q, const float* kv, const float* kr, int ld_kr, float* o) {
    __shared__ float Ks[16][96];
    __shared__ float Vs[16][64];
    const int h = blockIdx.y, qi = blockIdx.x * 256 + threadIdx.x;
    float qr[96], acc[64];
#pragma unroll
    for (int d = 0; d < 96; ++d) qr[d] = q[(size_t)qi * (H * QKH) + h * QKH + d] * ATTN_SCALE;
#pragma unroll
    for (int d = 0; d < 64; ++d) acc[d] = 0.f;
    float mx = -1e30f, l = 0.f;
    for (int k0 = 0; k0 < S; k0 += 16) {
        __syncthreads();
        for (int e = threadIdx.x; e < 16 * 96; e += 256) { const int j = e / 96, d = e % 96;
            Ks[j][d] = d < 64 ? kv[(size_t)(k0 + j) * (H * 128) + h * 128 + d] : kr[(size_t)(k0 + j) * ld_kr + (d - 64)]; }
        for (int e = threadIdx.x; e < 16 * 64; e += 256) { const int j = e >> 6, d = e & 63; Vs[j][d] = kv[(size_t)(k0 + j) * (H * 128) + h * 128 + 64 + d]; }
        __syncthreads();
        float s[16]; float tm = mx;
#pragma unroll
        for (int j = 0; j < 16; ++j) { float a = 0.f;
#pragma unroll
            for (int d = 0; d < 96; ++d) a += qr[d] * Ks[j][d];
            s[j] = a; tm = fmaxf(tm, a); }
        const float f = __expf(mx - tm); mx = tm; l *= f;
#pragma unroll
        for (int d = 0; d < 64; ++d) acc[d] *= f;
#pragma unroll
        for (int j = 0; j < 16; ++j) { const float p = __expf(s[j] - mx); l += p;
#pragma unroll
            for (int d = 0; d < 64; ++d) acc[d] += p * Vs[j][d]; }
    }
    const float il = 1.f / l;
#pragma unroll
    for (int d = 0; d < 64; ++d) o[(size_t)qi * (H * VH) + h * VH + d] = acc[d] * il;
}

__global__ void __launch_bounds__(256) k_conv(const float* proj, const float* w_dw, const float* b_dw, const float* g_ln, const float* b_ln, float* zc) {
    __shared__ float red[4];
    const int t = blockIdx.x;
    float v[2];
    for (int r = 0; r < 2; ++r) {
        const int c = threadIdx.x + 256 * r; float a = b_dw[c];
        for (int j = 0; j < CK; ++j) { const int tt = t + j - 15; if (tt < 0 || tt >= S) continue;
            const float u = proj[(size_t)tt * DIN + 416 + c], ug = proj[(size_t)tt * DIN + 928 + c];
            a += u * sigmoidf_(ug) * w_dw[j * CC + c]; }
        v[r] = a;
    }
    const float mean = block_sum_256(v[0] + v[1], red) * (1.f / CC);
    const float d0 = v[0] - mean, d1 = v[1] - mean;
    const float var = block_sum_256(d0 * d0 + d1 * d1, red) * (1.f / CC);
    const float rstd = rsqrtf(var + 1e-5f);
    for (int r = 0; r < 2; ++r) { const int c = threadIdx.x + 256 * r; const float y = (v[r] - mean) * rstd * g_ln[c] + b_ln[c]; zc[(size_t)t * CC + c] = siluf_(y); }
}

__global__ void __launch_bounds__(256) k_merge(const float* proj, const float* ya, const float* yb, float* mg) {
    const int m = blockIdx.x;
    for (int n = threadIdx.x; n < D; n += 256) mg[(size_t)m * D + n] = sigmoidf_(proj[(size_t)m * DIN + 1440 + n]) * ya[(size_t)m * D + n] + sigmoidf_(proj[(size_t)m * DIN + 2464 + n]) * yb[(size_t)m * D + n];
}
__global__ void __launch_bounds__(256) k_swiglu(const float* g, const float* u, float* a, size_t n) {
    const size_t i = (size_t)blockIdx.x * 256 + threadIdx.x; if (i < n) a[i] = siluf_(g[i]) * u[i];
}
}

extern "C" void kernel_launch(void* const* d_in, const int* in_sizes, int n_in, void* d_out, int out_size, void* d_ws, size_t ws_size, hipStream_t stream) {
    using namespace nv;
    const float* x = (const float*)d_in[0]; const float* c = (const float*)d_in[1]; const int* pos = (const int*)d_in[2];
    const float* w_ada = (const float*)d_in[3]; const float* b_ada = (const float*)d_in[4]; const float* g_mix = (const float*)d_in[5];
    const float* w_in = (const float*)d_in[6]; const float* g_qa = (const float*)d_in[7]; const float* w_qup = (const float*)d_in[8];
    const float* g_kva = (const float*)d_in[9]; const float* w_kvup = (const float*)d_in[10]; const float* w_ao = (const float*)d_in[11];
    const float* w_dw = (const float*)d_in[12]; const float* b_dw = (const float*)d_in[13]; const float* g_cln = (const float*)d_in[14];
    const float* b_cln = (const float*)d_in[15]; const float* w_co = (const float*)d_in[16]; const float* w_out = (const float*)d_in[17];
    const float* g_ffn = (const float*)d_in[18]; const float* w_fg = (const float*)d_in[19]; const float* w_fu = (const float*)d_in[20];
    const float* w_fd = (const float*)d_in[21]; const float* g_fin = (const float*)d_in[22];
    float* out = (float*)d_out;
    float* ws = (float*)d_ws;
    float* mod = ws;                          size_t o = 65536;
    float* hb = ws + o;     o += (size_t)S * D;
    float* proj = ws + o;   o += (size_t)S * DIN;
    float* qn = ws + o;     o += (size_t)S * QL;
    float* kvn = ws + o;    o += (size_t)S * KVL;
    float* qb = ws + o;     o += (size_t)S * H * QKH;
    float* kvb = ws + o;    o += (size_t)S * H * 128;
    float* ao = ws + o;     o += (size_t)S * H * VH;
    float* zc = ws + o;     o += (size_t)S * CC;
    float* ya = ws + o;     o += (size_t)S * D;
    float* yb = ws + o;     o += (size_t)S * D;
    float* mg = ws + o;     o += (size_t)S * D;
    float* x1 = ws + o;     o += (size_t)S * D;
    float* fg = ws + o;     o += (size_t)S * DFF;
    float* fu = ws + o;     o += (size_t)S * DFF;
    float* fa = ws + o;     o += (size_t)S * DFF;
    float* x2 = ws + o;     o += (size_t)S * D;

    hipLaunchKernelGGL(k_mod, dim3(NMOD * D / 256, B), dim3(256), 0, stream, c, w_ada, b_ada, mod);
    for (int b = 0; b < B; ++b) {
        const float* xb = x + (size_t)b * S * D; const float* mb = mod + (size_t)b * NMOD * D; const int* pb = pos + b * S;
        const float *shift_m = mb, *scale_m = mb + D, *gate_m = mb + 2 * D, *shift_f = mb + 3 * D, *scale_f = mb + 4 * D, *gate_f = mb + 5 * D;
        hipLaunchKernelGGL(k_rms, dim3(S), dim3(256), 0, stream, xb, D, hb, D, D, g_mix, scale_m, shift_m, 1e-6f);
        hipLaunchKernelGGL(k_gemm<0>, dim3((DIN + 63) / 64, S / 64), dim3(256), 0, stream, hb, D, w_in, DIN, proj, DIN, S, DIN, D, nullptr, 0, nullptr);
        hipLaunchKernelGGL(k_rms, dim3(S), dim3(256), 0, stream, proj, DIN, qn, QL, QL, g_qa, nullptr, nullptr, 1e-6f);
        hipLaunchKernelGGL(k_rms, dim3(S), dim3(256), 0, stream, proj + 256, DIN, kvn, KVL, KVL, g_kva, nullptr, nullptr, 1e-6f);
        hipLaunchKernelGGL(k_gemm<0>, dim3(H * QKH / 64, S / 64), dim3(256), 0, stream, qn, QL, w_qup, H * QKH, qb, H * QKH, S, H * QKH, QL, nullptr, 0, nullptr);
        hipLaunchKernelGGL(k_gemm<0>, dim3(H * 128 / 64, S / 64), dim3(256), 0, stream, kvn, KVL, w_kvup, H * 128, kvb, H * 128, S, H * 128, KVL, nullptr, 0, nullptr);
        hipLaunchKernelGGL(k_rope, dim3(S * H * 16 / 256), dim3(256), 0, stream, qb, H * QKH, 64, QKH, H, pb, S);
        hipLaunchKernelGGL(k_rope, dim3(S * 16 / 256), dim3(256), 0, stream, proj, DIN, 384, 0, 1, pb, S);
        hipLaunchKernelGGL(k_attn, dim3(S / 256, H), dim3(256), 0, stream, qb, kvb, proj + 384, DIN, ao);
        hipLaunchKernelGGL(k_gemm<0>, dim3(D / 64, S / 64), dim3(256), 0, stream, ao, H * VH, w_ao, D, ya, D, S, D, H * VH, nullptr, 0, nullptr);
        hipLaunchKernelGGL(k_conv, dim3(S), dim3(256), 0, stream, proj, w_dw, b_dw, g_cln, b_cln, zc);
        hipLaunchKernelGGL(k_gemm<0>, dim3(D / 64, S / 64), dim3(256), 0, stream, zc, CC, w_co, D, yb, D, S, D, CC, nullptr, 0, nullptr);
        hipLaunchKernelGGL(k_merge, dim3(S), dim3(256), 0, stream, proj, ya, yb, mg);
        hipLaunchKernelGGL(k_gemm<1>, dim3(D / 64, S / 64), dim3(256), 0, stream, mg, D, w_out, D, x1, D, S, D, D, xb, D, gate_m);
        hipLaunchKernelGGL(k_rms, dim3(S), dim3(256), 0, stream, x1, D, hb, D, D, g_ffn, scale_f, shift_f, 1e-6f);
        hipLaunchKernelGGL(k_gemm<0>, dim3(DFF / 64, S / 64), dim3(256), 0, stream, hb, D, w_fg, DFF, fg, DFF, S, DFF, D, nullptr, 0, nullptr);
        hipLaunchKernelGGL(k_gemm<0>, dim3(DFF / 64, S / 64), dim3(256), 0, stream, hb, D, w_fu, DFF, fu, DFF, S, DFF, D, nullptr, 0, nullptr);
        hipLaunchKernelGGL(k_swiglu, dim3((unsigned)(((size_t)S * DFF + 255) / 256)), dim3(256), 0, stream, fg, fu, fa, (size_t)S * DFF);
        hipLaunchKernelGGL(k_gemm<1>, dim3(D / 64, S / 64), dim3(256), 0, stream, fa, DFF, w_fd, D, x2, D, S, D, DFF, x1, D, gate_f);
        hipLaunchKernelGGL(k_rms, dim3(S), dim3(256), 0, stream, x2, D, out + (size_t)b * S * D, D, D, g_fin, nullptr, nullptr, 1e-6f);
    }
}
```

```cpp
#define MK_PER_PHASE 1
#include <hip/hip_runtime.h>
#include <hip/hip_bf16.h>
#include <cstdio>
#include <cstdint>
#include <cmath>
namespace pg8 {
#define PG8_LAS __attribute__((address_space(3)))
typedef unsigned short bf16_t;
typedef short bf16x8 __attribute__((ext_vector_type(8)));
typedef float f32x4 __attribute__((ext_vector_type(4)));
typedef unsigned u32x4 __attribute__((ext_vector_type(4)));
constexpr int BM = 256, BK = 64, HALF = 128, HTB = HALF * BK * 2  , STAGE_BYTES = 8 * HTB, NXCD = 8, WGM = 8;

__host__ __device__ __forceinline__ int lds_byte(int r, int c) { const int st = (r >> 4) * 2 + (c >> 5), rr = r & 15, cc = c & 31, ob = rr * 64 + cc * 2; return st * 1024 + (ob ^ (((ob >> 9) & 1) << 5)); }
__host__ __device__ __forceinline__ void stage_rc(int b, int& R, int& C) { const int st = b / 1024, sb = b % 1024, swz = sb ^ (((sb >> 9) & 1) << 5); R = (st >> 1) * 16 + swz / 64; C = (st & 1) * 32 + (swz % 64) / 2; }
__host__ __device__ __forceinline__ int perm32(int rho) { const int n = rho >> 4, i = rho & 15; return 8 * (i >> 2) + 4 * n + (i & 3); }

struct Unit { int pm, pn; };
struct Gemm { const bf16_t* A; const bf16_t* Bt; int M, N, K; };

struct StaticOrder {
    int nM, nN, nwg, G, c;
    __host__ __device__ void init(int M, int N, int G_, int c_) { nM = M / BM; nN = N / BM; nwg = nM * nN; G = G_; c = c_; }
    __host__ __device__ bool next(int i, Unit& u) const {
        const long L = (long)i * G + c; if (L >= nwg) return false;
        int wgid = (int)L; { const int q = nwg / NXCD, r = nwg % NXCD, xcd = wgid % NXCD, off = wgid / NXCD; wgid = (xcd < r ? xcd * (q + 1) : r * (q + 1) + (xcd - r) * q) + off; }
        const int nig = WGM * nN, gid = wgid / nig, fm = gid * WGM, gsz = (nM - fm) < WGM ? (nM - fm) : WGM;
        u.pm = fm + ((wgid % nig) % gsz); u.pn = (wgid % nig) / gsz; return true;
    }
    __device__ __forceinline__ void a_ready(const Unit&) const {}
    __device__ __forceinline__ void done(const Unit&) const {}
};


typedef float f32x2_t __attribute__((ext_vector_type(2))); typedef __bf16 bf16x2_t __attribute__((ext_vector_type(2)));
__device__ __forceinline__ unsigned cvt_pk_bf16(float lo, float hi) { f32x2_t v = {lo, hi}; bf16x2_t b = __builtin_convertvector(v, bf16x2_t); return __builtin_bit_cast(unsigned, b); }
__device__ __forceinline__ float sigm(float v) { return __builtin_amdgcn_rcpf(1.f + __builtin_amdgcn_exp2f(-1.4426950408889634f * v)); }
__device__ __forceinline__ f32x4 sigm4(f32x4 v) { return (f32x4){sigm(v[0]), sigm(v[1]), sigm(v[2]), sigm(v[3])}; }
__device__ __forceinline__ u32x4 pack8(f32x4 a, f32x4 b) { u32x4 w; w.x = cvt_pk_bf16(a[0], a[1]); w.y = cvt_pk_bf16(a[2], a[3]); w.z = cvt_pk_bf16(b[0], b[1]); w.w = cvt_pk_bf16(b[2], b[3]); return w; }
__device__ __forceinline__ f32x4 unpk_lo(u32x4 w) { return (f32x4){__uint_as_float(w.x << 16), __uint_as_float(w.x & 0xffff0000u), __uint_as_float(w.y << 16), __uint_as_float(w.y & 0xffff0000u)}; }
__device__ __forceinline__ f32x4 unpk_hi(u32x4 w) { return (f32x4){__uint_as_float(w.z << 16), __uint_as_float(w.z & 0xffff0000u), __uint_as_float(w.w << 16), __uint_as_float(w.w & 0xffff0000u)}; }

struct EpiProj {
    static constexpr bool PERM = true, AFTER_DRAIN = false;
    bf16_t *QA, *KVA, *KR, *Z, *SGA, *SGB;
    __device__ __forceinline__ void operator()(const f32x4 (&acc)[2][2][4][2], const Unit& u, int wr, int wc, int fr, int fq) const {
        const int row0 = u.pm * BM + wr * 64 + fr, cw = wc * 32 + 8 * fq, pn = u.pn;
        if (pn >= 2 && pn < 6) {
#pragma unroll
            for (int ai = 0; ai < 2; ++ai)
#pragma unroll
                for (int m = 0; m < 4; ++m) { const size_t row = (size_t)(row0 + ai * HALF + m * 16);
                    const f32x4 z0 = acc[ai][0][m][0] * sigm4(acc[ai][1][m][0]), z1 = acc[ai][0][m][1] * sigm4(acc[ai][1][m][1]);
                    *(u32x4*)(Z + row * 512 + (pn - 2) * 128 + cw) = pack8(z0, z1); }
        } else if (pn >= 6) {
            bf16_t* base = pn < 10 ? SGA : SGB; const int ct = (pn < 10 ? pn - 6 : pn - 10) * 256;
#pragma unroll
            for (int ai = 0; ai < 2; ++ai)
#pragma unroll
                for (int m = 0; m < 4; ++m) { const size_t row = (size_t)(row0 + ai * HALF + m * 16);
#pragma unroll
                    for (int bj = 0; bj < 2; ++bj) *(u32x4*)(base + row * 1024 + ct + bj * HALF + cw) = pack8(sigm4(acc[ai][bj][m][0]), sigm4(acc[ai][bj][m][1])); }
        } else if (pn == 0) {
#pragma unroll
            for (int ai = 0; ai < 2; ++ai)
#pragma unroll
                for (int m = 0; m < 4; ++m) { const size_t row = (size_t)(row0 + ai * HALF + m * 16);
#pragma unroll
                    for (int bj = 0; bj < 2; ++bj) *(u32x4*)(QA + row * 256 + bj * HALF + cw) = pack8(acc[ai][bj][m][0], acc[ai][bj][m][1]); }
        } else {
#pragma unroll
            for (int ai = 0; ai < 2; ++ai)
#pragma unroll
                for (int m = 0; m < 4; ++m) { const size_t row = (size_t)(row0 + ai * HALF + m * 16);
                    *(u32x4*)(KVA + row * 256 + cw) = pack8(acc[ai][0][m][0], acc[ai][0][m][1]);
                    *(u32x4*)(KVA + row * 256 + HALF + cw) = (u32x4){0u, 0u, 0u, 0u};
                    if (wc == 0) *(u32x4*)(KR + row * 32 + 8 * fq) = pack8(acc[ai][1][m][0], acc[ai][1][m][1]); }
        }
    }
};
struct EpiQup {
    static constexpr bool PERM = true, AFTER_DRAIN = false;
    bf16_t* Q; const float* RC; const float* RS;
    __device__ __forceinline__ void operator()(const f32x4 (&acc)[2][2][4][2], const Unit& u, int wr, int wc, int fr, int fq) const {
        const int srow = (u.pm & 7) * BM + wr * 64 + fr, grow = u.pm * BM + wr * 64 + fr;
#pragma unroll
        for (int bj = 0; bj < 2; ++bj) { const int G = 8 * u.pn + 4 * bj + wc, head = G / 3, sect = G - 3 * head;
            bf16_t* qp = Q + ((size_t)((u.pm >> 3) * 8 + head) * 2048 + srow) * 96 + 32 * sect + 8 * fq;
            const float* rc = RC + (size_t)grow * 16 + 8 * (fq & 1); const float* rs = RS + (size_t)grow * 16 + 8 * (fq & 1);
#pragma unroll
            for (int ai = 0; ai < 2; ++ai)
#pragma unroll
                for (int m = 0; m < 4; ++m) { const int dr = ai * HALF + m * 16;
                    asm volatile("" : "+v"(qp), "+v"(rc), "+v"(rs));
                    f32x4 v0 = acc[ai][bj][m][0], v1 = acc[ai][bj][m][1];
                    if (sect == 2) {
                        { const f32x4 c0 = *(const f32x4*)(rc + dr * 16), s0 = *(const f32x4*)(rs + dr * 16); f32x4 p0;
#pragma unroll
                          for (int j = 0; j < 4; ++j) p0[j] = __shfl_xor(v0[j], 32);
                          v0 = (fq < 2) ? v0 * c0 - p0 * s0 : v0 * c0 + p0 * s0; asm volatile("" : "+v"(v0)); }
                        { const f32x4 c1 = *(const f32x4*)(rc + dr * 16 + 4), s1 = *(const f32x4*)(rs + dr * 16 + 4); f32x4 p1;
#pragma unroll
                          for (int j = 0; j < 4; ++j) p1[j] = __shfl_xor(v1[j], 32);
                          v1 = (fq < 2) ? v1 * c1 - p1 * s1 : v1 * c1 + p1 * s1; asm volatile("" : "+v"(v1)); }
                    }
                    *(u32x4*)(qp + dr * 96) = pack8(v0, v1); } }
    }
};
struct EpiKVup {
    static constexpr bool PERM = true, AFTER_DRAIN = false;
    bf16_t* K; bf16_t* V;
    __device__ __forceinline__ void operator()(const f32x4 (&acc)[2][2][4][2], const Unit& u, int wr, int wc, int fr, int fq) const {
        const int srow = (u.pm & 7) * BM + wr * 64 + fr;
#pragma unroll
        for (int bj = 0; bj < 2; ++bj) { const int G = 8 * u.pn + 4 * bj + wc, head = G >> 2, sect = G & 3;
            const size_t tk = (size_t)((u.pm >> 3) * 8 + head) * 2048 + srow;
            bf16_t* dp = sect < 2 ? K + tk * 96 + 32 * sect + 8 * fq : V + tk * 64 + 32 * (sect - 2) + 8 * fq;
            const int pitch = sect < 2 ? 96 : 64;
#pragma unroll
            for (int ai = 0; ai < 2; ++ai)
#pragma unroll
                for (int m = 0; m < 4; ++m) { asm volatile("" : "+v"(dp));
                    *(u32x4*)(dp + (ai * HALF + m * 16) * pitch) = pack8(acc[ai][bj][m][0], acc[ai][bj][m][1]); } }
    }
};
struct EpiMulGate {
    static constexpr bool PERM = true, AFTER_DRAIN = false;
    bf16_t* G;
    __device__ __forceinline__ void operator()(const f32x4 (&acc)[2][2][4][2], const Unit& u, int wr, int wc, int fr, int fq) const {
        const int row0 = u.pm * BM + wr * 64 + fr, c0 = u.pn * BM + wc * 32 + 8 * fq;
#pragma unroll
        for (int ai = 0; ai < 2; ++ai)
#pragma unroll
            for (int m = 0; m < 4; ++m) { const size_t row = (size_t)(row0 + ai * HALF + m * 16);
#pragma unroll
                for (int bj = 0; bj < 2; ++bj) { u32x4* p = (u32x4*)(G + row * 1024 + c0 + bj * HALF); const u32x4 g = *p;
                    *p = pack8(unpk_lo(g) * acc[ai][bj][m][0], unpk_hi(g) * acc[ai][bj][m][1]); } }
    }
};
struct EpiMerge {
    static constexpr bool PERM = true, AFTER_DRAIN = false;
    bf16_t* G; const bf16_t* T;
    __device__ __forceinline__ void operator()(const f32x4 (&acc)[2][2][4][2], const Unit& u, int wr, int wc, int fr, int fq) const {
        const int row0 = u.pm * BM + wr * 64 + fr, c0 = u.pn * BM + wc * 32 + 8 * fq;
#pragma unroll
        for (int ai = 0; ai < 2; ++ai)
#pragma unroll
            for (int m = 0; m < 4; ++m) { const size_t row = (size_t)(row0 + ai * HALF + m * 16);
#pragma unroll
                for (int bj = 0; bj < 2; ++bj) { u32x4* p = (u32x4*)(G + row * 1024 + c0 + bj * HALF); const u32x4 g = *p; const u32x4 t = *(const u32x4*)(T + row * 1024 + c0 + bj * HALF);
                    *p = pack8(unpk_lo(g) * acc[ai][bj][m][0] + unpk_lo(t), unpk_hi(g) * acc[ai][bj][m][1] + unpk_hi(t)); } }
    }
};
struct EpiResid {
    static constexpr bool PERM = false, AFTER_DRAIN = false;
    const float* R; float* O; const float* gate;
    __device__ __forceinline__ void operator()(const f32x4 (&acc)[2][2][4][2], const Unit& u, int wr, int wc, int fr, int fq) const {
        const int row0 = u.pm * BM + wr * 64 + fr, col0 = u.pn * BM + wc * 32 + 4 * fq; const float* gb = gate + (size_t)(u.pm >> 3) * 6144 + col0;
        f32x4 gv[2][2];
#pragma unroll
        for (int bj = 0; bj < 2; ++bj)
#pragma unroll
            for (int n = 0; n < 2; ++n) gv[bj][n] = *(const f32x4*)(gb + bj * HALF + n * 16);
#pragma unroll
        for (int ai = 0; ai < 2; ++ai)
#pragma unroll
            for (int m = 0; m < 4; ++m) { const size_t off = (size_t)(row0 + ai * HALF + m * 16) * 1024 + col0;
#pragma unroll
                for (int bj = 0; bj < 2; ++bj)
#pragma unroll
                    for (int n = 0; n < 2; ++n) { const f32x4 r = *(const f32x4*)(R + off + bj * HALF + n * 16); *(f32x4*)(O + off + bj * HALF + n * 16) = r + gv[bj][n] * acc[ai][bj][m][n]; } }
    }
};
struct EpiSwiGLU {
    static constexpr bool PERM = true, AFTER_DRAIN = false;
    bf16_t* ACT;
    __device__ __forceinline__ void operator()(const f32x4 (&acc)[2][2][4][2], const Unit& u, int wr, int wc, int fr, int fq) const {
        const int row0 = u.pm * BM + wr * 64 + fr, c0 = u.pn * 128 + wc * 32 + 8 * fq;
#pragma unroll
        for (int ai = 0; ai < 2; ++ai)
#pragma unroll
            for (int m = 0; m < 4; ++m) { const size_t row = (size_t)(row0 + ai * HALF + m * 16);
                const f32x4 g0 = acc[ai][0][m][0], g1 = acc[ai][0][m][1];
                *(u32x4*)(ACT + row * 2816 + c0) = pack8(g0 * sigm4(g0) * acc[ai][1][m][0], g1 * sigm4(g1) * acc[ai][1][m][1]); }
    }
};

template <class Epi, class Sched, bool ALIGN_EPI = false, bool SP2 = false>
__device__ __forceinline__ void gemm_phase(PG8_LAS unsigned char* lds, const Gemm g, const Sched& S, const Epi& E) {
    int tid_ = threadIdx.x; asm volatile("" : "+v"(tid_));
    const int tid = tid_, wid = __builtin_amdgcn_readfirstlane(tid >> 6), lane = tid & 63, wr = wid >> 2, wc = wid & 3, fr = lane & 15, fq = lane >> 4;
    const int K = g.K, nt = K / BK;
    unsigned voffA[2], voffB[2];
#pragma unroll
    for (int i = 0; i < 2; ++i) { int R, C; stage_rc(tid * 16 + i * 8192, R, C); const int Rb = Epi::PERM ? ((R & ~31) + perm32(R & 31)) : R;
        voffA[i] = (unsigned)(R * K + C) * 2u; voffB[i] = (unsigned)(Rb * K + C) * 2u; }
    const size_t kstep = (size_t)(BK * 2);
    const size_t hstep = (size_t)HALF * K * 2;
    const size_t tstep = 2 * hstep;
    const unsigned ldsw = (unsigned)wid * 1024u;
    const int aoff = lds_byte(wr * 64 + fr, fq * 8), boff = lds_byte(wc * 32 + fr, fq * 8);
#define PG8_SA(b, h) (((b) * 2 + (h)) * HTB)
#define PG8_SB(b, h) ((4 + (b) * 2 + (h)) * HTB)
#define PG8_STAGE(bufoff, gbase, voff) do { _Pragma("unroll") for (int _i = 0; _i < 2; ++_i) \
        __builtin_amdgcn_global_load_lds((const unsigned*)((const char*)(gbase) + (voff)[_i]), (PG8_LAS unsigned*)(lds + (bufoff) + ldsw + _i * 8192), 16, 0, 0); } while (0)
#define PG8_LDA(dst, b, h) do { _Pragma("unroll") for (int m = 0; m < 4; ++m) _Pragma("unroll") for (int k = 0; k < 2; ++k) dst[m][k] = *(const PG8_LAS bf16x8*)(lds + PG8_SA(b, h) + aoff + m * 2048 + k * 1024); } while (0)
#define PG8_LDB(dst, b, h) do { _Pragma("unroll") for (int n = 0; n < 2; ++n) _Pragma("unroll") for (int k = 0; k < 2; ++k) dst[n][k] = *(const PG8_LAS bf16x8*)(lds + PG8_SB(b, h) + boff + n * 2048 + k * 1024); } while (0)
#define PG8_MMA(ai, bj, At, Bt) do { __builtin_amdgcn_s_setprio(1); _Pragma("unroll") for (int m = 0; m < 4; ++m) _Pragma("unroll") for (int n = 0; n < 2; ++n) _Pragma("unroll") for (int k = 0; k < 2; ++k) \
        acc[ai][bj][m][n] = __builtin_amdgcn_mfma_f32_16x16x32_bf16(Bt[n][k], At[m][k], acc[ai][bj][m][n], 0, 0, 0); __builtin_amdgcn_s_setprio(0); } while (0)
#define PG8_WAIT_V(n) asm volatile("s_waitcnt vmcnt(" #n ")" ::: "memory")
#define PG8_WAIT_L(n) asm volatile("s_waitcnt lgkmcnt(" #n ")" ::: "memory")
#define PG8_BAR __builtin_amdgcn_s_barrier()
#define PG8_SCHED __builtin_amdgcn_sched_barrier(0)
    Unit cur, nxt; int ui = 0;
    if (!S.next(0, cur)) return;
    f32x4 acc[2][2][4][2];
#pragma unroll
    for (int a = 0; a < 2; ++a)
#pragma unroll
        for (int b = 0; b < 2; ++b)
#pragma unroll
            for (int m = 0; m < 4; ++m)
#pragma unroll
                for (int n = 0; n < 2; ++n) acc[a][b][m][n] = (f32x4){0.f, 0.f, 0.f, 0.f};
    bf16x8 At[4][2], B0[2][2], B1[2][2];
    const char* cA = (const char*)g.A + (size_t)cur.pm * tstep; const char* cB = (const char*)g.Bt + (size_t)cur.pn * tstep;
    S.a_ready(cur);
    if constexpr (SP2) {
        PG8_STAGE(PG8_SB(0, 0), cB, voffB); PG8_STAGE(PG8_SB(0, 1), cB + hstep, voffB); PG8_STAGE(PG8_SA(0, 0), cA, voffA); PG8_STAGE(PG8_SA(0, 1), cA + hstep, voffA);
        if (wr == 1) PG8_BAR;
        PG8_WAIT_V(2); PG8_BAR;
        PG8_STAGE(PG8_SB(1, 0), cB + kstep, voffB); PG8_STAGE(PG8_SA(1, 0), cA + kstep, voffA); PG8_STAGE(PG8_SB(1, 1), cB + hstep + kstep, voffB);
        PG8_WAIT_V(6); PG8_BAR;
    } else {
        PG8_STAGE(PG8_SB(0, 0), cB, voffB); PG8_STAGE(PG8_SA(0, 0), cA, voffA); PG8_STAGE(PG8_SB(0, 1), cB + hstep, voffB); PG8_STAGE(PG8_SA(0, 1), cA + hstep, voffA);
        if (wr == 1) PG8_BAR;
        PG8_WAIT_V(4); PG8_BAR;
        PG8_STAGE(PG8_SB(1, 0), cB + kstep, voffB); PG8_STAGE(PG8_SA(1, 0), cA + kstep, voffA); PG8_STAGE(PG8_SB(1, 1), cB + hstep + kstep, voffB);
        PG8_WAIT_V(6); PG8_BAR;
    }
    for (;;) {
        const bool has_next = S.next(ui + 1, nxt);
        const char* nA = has_next ? (const char*)g.A + (size_t)nxt.pm * tstep : cA; const char* nB = has_next ? (const char*)g.Bt + (size_t)nxt.pn * tstep : cB;
        for (int t = 0; t < nt; t += 2) {
            const bool last = (t == nt - 2);
            const char* a1 = cA + (size_t)(t + 1) * kstep;
            const char* a2 = last ? nA : cA + (size_t)(t + 2) * kstep; const char* b2 = last ? nB : cB + (size_t)(t + 2) * kstep;
            const char* a3 = a2 + kstep; const char* b3 = b2 + kstep;
            if (last && has_next) S.a_ready(nxt);
            if constexpr (SP2) {
            PG8_LDB(B0, 0, 0); PG8_LDB(B1, 0, 1); PG8_SCHED; PG8_LDA(At, 0, 0); PG8_STAGE(PG8_SA(1, 1), a1 + hstep, voffA);
            PG8_WAIT_V(8); PG8_WAIT_L(0); PG8_BAR; PG8_MMA(0, 0, At, B0); PG8_MMA(0, 1, At, B1); PG8_BAR; PG8_SCHED;
            PG8_LDA(At, 0, 1); PG8_STAGE(PG8_SB(0, 0), b2, voffB); PG8_STAGE(PG8_SB(0, 1), b2 + hstep, voffB); PG8_STAGE(PG8_SA(0, 0), a2, voffA);
            PG8_WAIT_V(8); PG8_WAIT_L(0); PG8_BAR; PG8_MMA(1, 0, At, B0); PG8_MMA(1, 1, At, B1); PG8_BAR; PG8_SCHED;
            PG8_LDB(B0, 1, 0); PG8_LDB(B1, 1, 1); PG8_SCHED; PG8_LDA(At, 1, 0); PG8_STAGE(PG8_SA(0, 1), a2 + hstep, voffA);
            PG8_WAIT_V(8); PG8_WAIT_L(0); PG8_BAR; PG8_MMA(0, 0, At, B0); PG8_MMA(0, 1, At, B1); PG8_BAR; PG8_SCHED;
            PG8_LDA(At, 1, 1); PG8_STAGE(PG8_SB(1, 0), b3, voffB); PG8_STAGE(PG8_SB(1, 1), b3 + hstep, voffB); PG8_STAGE(PG8_SA(1, 0), a3, voffA);
            PG8_WAIT_V(8); PG8_WAIT_L(0); PG8_BAR; PG8_MMA(1, 0, At, B0); PG8_MMA(1, 1, At, B1); PG8_BAR; PG8_SCHED;
            } else {
            PG8_LDB(B0, 0, 0); PG8_SCHED; PG8_LDA(At, 0, 0); PG8_STAGE(PG8_SA(1, 1), a1 + hstep, voffA);
            PG8_WAIT_L(8); PG8_BAR; PG8_WAIT_L(0); PG8_MMA(0, 0, At, B0); PG8_BAR; PG8_SCHED;
            PG8_LDB(B1, 0, 1); PG8_STAGE(PG8_SB(0, 0), b2, voffB);
            PG8_BAR; PG8_WAIT_L(0); PG8_MMA(0, 1, At, B1); PG8_BAR;
            PG8_LDA(At, 0, 1); PG8_STAGE(PG8_SA(0, 0), a2, voffA);
            PG8_BAR; PG8_WAIT_L(0); PG8_MMA(1, 0, At, B0); PG8_BAR; PG8_SCHED;
            PG8_STAGE(PG8_SB(0, 1), b2 + hstep, voffB);
            PG8_WAIT_V(6); PG8_BAR; PG8_MMA(1, 1, At, B1); PG8_BAR;
            PG8_LDB(B0, 1, 0); PG8_SCHED; PG8_LDA(At, 1, 0); PG8_STAGE(PG8_SA(0, 1), a2 + hstep, voffA);
            PG8_WAIT_L(8); PG8_BAR; PG8_WAIT_L(0); PG8_MMA(0, 0, At, B0); PG8_BAR; PG8_SCHED;
            PG8_LDB(B1, 1, 1); PG8_STAGE(PG8_SB(1, 0), b3, voffB);
            PG8_BAR; PG8_WAIT_L(0); PG8_MMA(0, 1, At, B1); PG8_BAR;
            PG8_LDA(At, 1, 1); PG8_STAGE(PG8_SA(1, 0), a3, voffA);
            PG8_BAR; PG8_WAIT_L(0); PG8_MMA(1, 0, At, B0); PG8_BAR; PG8_SCHED;
            PG8_STAGE(PG8_SB(1, 1), b3 + hstep, voffB);
            PG8_WAIT_V(6); PG8_BAR; PG8_MMA(1, 1, At, B1); PG8_BAR;
            }
        }
        if constexpr (ALIGN_EPI) { if (wr == 0) PG8_BAR; }
        if constexpr (!Epi::AFTER_DRAIN) { E(acc, cur, wr, wc, fr, fq); S.done(cur); }
        if (!has_next) break;
#pragma unroll
        for (int a = 0; a < 2; ++a)
#pragma unroll
            for (int b = 0; b < 2; ++b)
#pragma unroll
                for (int m = 0; m < 4; ++m)
#pragma unroll
                    for (int n = 0; n < 2; ++n) acc[a][b][m][n] = (f32x4){0.f, 0.f, 0.f, 0.f};
        cur = nxt; cA = nA; cB = nB; ++ui;
        if constexpr (ALIGN_EPI) { if (wr == 1) PG8_BAR; }
    }
    PG8_WAIT_V(0);
    if constexpr (!ALIGN_EPI) { if (wr == 0) PG8_BAR; }
    PG8_BAR;
    if constexpr (Epi::AFTER_DRAIN) { E.fused(acc, cur, wr, wc, fr, fq, lds, wid, lane); S.done(cur); }
#undef PG8_SA
#undef PG8_SB
#undef PG8_STAGE
#undef PG8_LDA
#undef PG8_LDB
#undef PG8_MMA
#undef PG8_WAIT_V
#undef PG8_WAIT_L
#undef PG8_BAR
#undef PG8_SCHED
}
}

namespace att {
using bf16 = unsigned short;
using bf16x8 = __attribute__((ext_vector_type(8))) short;
using s16x4  = __attribute__((ext_vector_type(4))) short;
using f32x16 = __attribute__((ext_vector_type(16))) float;
using u32x4  = __attribute__((ext_vector_type(4))) unsigned;
constexpr int DQK = 96, DV = 64, NW = 8, QBLK = 32, KVBLK = 64, SEQ = 2048;
constexpr float SCALE = 0.10206207261596577f;
#ifndef ATTN_THR
#define ATTN_THR 0.f
#endif
constexpr float THR = ATTN_THR;
constexpr int SHM_V = KVBLK * DV * 2  , SHM_K = KVBLK * 256  ;
constexpr int LDS_V = 0, LDS_K = 2 * SHM_V, LDS_WS = LDS_K + 2 * SHM_K, LDS_OST = LDS_WS + NW * 64 * 4, LDS_BYTES = LDS_OST + NW * 4096;
#define KSWZ(row, colB) ((row) * 256 + ((colB) ^ (((row) & 7) << 4)))
#define SBAR() __builtin_amdgcn_sched_barrier(0)
__device__ __forceinline__ int crow(int r, int hi) { return (r & 3) + 8 * (r >> 2) + 4 * hi; }
typedef float f32x2_t __attribute__((ext_vector_type(2))); typedef __bf16 bf16x2_t __attribute__((ext_vector_type(2)));
__device__ __forceinline__ unsigned cvtpk(float lo, float hi) { f32x2_t v = {lo, hi}; bf16x2_t b = __builtin_convertvector(v, bf16x2_t); return __builtin_bit_cast(unsigned, b); }

__device__ __forceinline__ void partialSM(f32x16& p0, f32x16& p1, float& m_reg, float& mn, float& alpha) {
  constexpr float C = SCALE * 1.4426950408889634f;
  float pmax = p0[0];
#pragma unroll
  for (int r = 1; r < 16; ++r) pmax = fmaxf(pmax, p0[r]);
#pragma unroll
  for (int r = 0; r < 16; ++r) pmax = fmaxf(pmax, p1[r]);
  { auto rr = __builtin_amdgcn_permlane32_swap(__float_as_uint(pmax), __float_as_uint(pmax), false, false);
    pmax = fmaxf(__uint_as_float(rr[0]), __uint_as_float(rr[1])); }
  if (__builtin_expect(__all(pmax - m_reg <= THR / SCALE), 1)) { mn = m_reg; alpha = 1.f; }
  else { mn = fmaxf(m_reg, pmax); alpha = __builtin_amdgcn_exp2f((m_reg - mn) * C); m_reg = mn; }
  const float mnC = -mn * C;
#pragma unroll
  for (int r = 0; r < 16; ++r) p0[r] = fmaf(p0[r], C, mnC);
#pragma unroll
  for (int r = 0; r < 16; ++r) p1[r] = fmaf(p1[r], C, mnC);
#pragma unroll
  for (int r = 0; r < 16; ++r) p0[r] = __builtin_amdgcn_exp2f(p0[r]);
}
__device__ __forceinline__ void finishSM(f32x16& p0, f32x16& p1, float alpha, float& l_reg, bf16x8& pa0, bf16x8& pa1, bf16x8& pa2, bf16x8& pa3) {
#pragma unroll
  for (int r = 0; r < 16; ++r) p1[r] = __builtin_amdgcn_exp2f(p1[r]);
  float ps = 0;
#pragma unroll
  for (int r = 0; r < 16; ++r) ps += p0[r];
#pragma unroll
  for (int r = 0; r < 16; ++r) ps += p1[r];
  { auto rr = __builtin_amdgcn_permlane32_swap(__float_as_uint(ps), __float_as_uint(ps), false, false);
    ps = __uint_as_float(rr[0]) + __uint_as_float(rr[1]); }
  l_reg = l_reg * alpha + ps;
#define PK4(P, BASE, OUT) do { unsigned a0 = cvtpk(P[BASE + 0], P[BASE + 1]), a1 = cvtpk(P[BASE + 2], P[BASE + 3]);   \
    unsigned b0 = cvtpk(P[BASE + 4], P[BASE + 5]), b1 = cvtpk(P[BASE + 6], P[BASE + 7]);                              \
    auto r0 = __builtin_amdgcn_permlane32_swap(a0, b0, false, false); auto r1 = __builtin_amdgcn_permlane32_swap(a1, b1, false, false); \
    u32x4 w = {r0[0], r1[0], r0[1], r1[1]}; OUT = *reinterpret_cast<bf16x8*>(&w); } while (0)
  PK4(p0, 0, pa0); PK4(p0, 8, pa1); PK4(p1, 0, pa2); PK4(p1, 8, pa3);
#undef PK4
}
__device__ __forceinline__ void qkt(f32x16& p0, f32x16& p1, const char* Ks, const bf16x8* qr, int r32, int hi) {
  p0 = f32x16{}; p1 = f32x16{};
#pragma unroll
  for (int d0 = 0; d0 < DQK / 16; ++d0) { const int cb = (d0 * 16 + hi * 8) * 2;
    const bf16x8 b0 = *reinterpret_cast<const bf16x8*>(Ks + KSWZ(r32, cb));
    const bf16x8 b1 = *reinterpret_cast<const bf16x8*>(Ks + KSWZ(32 + r32, cb));
    p0 = __builtin_amdgcn_mfma_f32_32x32x16_bf16(b0, qr[d0], p0, 0, 0, 0);
    p1 = __builtin_amdgcn_mfma_f32_32x32x16_bf16(b1, qr[d0], p1, 0, 0, 0); }
}
__device__ __forceinline__ int v_st(int k, int c) { const int kk = (k & ~0xC) | ((k & 4) << 1) | ((k & 8) >> 1); return ((kk >> 3) * 2 + (c >> 5)) * 512 + ((kk & 7) * 32 + (c & 31)) * 2; }
__device__ __forceinline__ int v_rd_base(int lane) { return ((lane & 3) << 3) | (((lane >> 2) & 3) << 6) | (((lane >> 4) & 1) << 5) | (((lane >> 5) & 1) << 8); }
constexpr int v_rd_off(int d0, int ks, int half) { return d0 * 512 + ks * 2048 + half * 1024; }
template <int OFF> __device__ __forceinline__ s16x4 tr_read(int vb) {
  s16x4 r; asm volatile("ds_read_b64_tr_b16 %0, %1 offset:%2" : "=&v"(r) : "v"(vb), "i"(OFF) : "memory"); return r;
}
template <int D0> __device__ __forceinline__ void pv_one(f32x16& od, int vb, bf16x8 pa0, bf16x8 pa1, bf16x8 pa2, bf16x8 pa3) {
  const s16x4 l0 = tr_read<v_rd_off(D0, 0, 0)>(vb), h0 = tr_read<v_rd_off(D0, 0, 1)>(vb), l1 = tr_read<v_rd_off(D0, 1, 0)>(vb), h1 = tr_read<v_rd_off(D0, 1, 1)>(vb);
  const s16x4 l2 = tr_read<v_rd_off(D0, 2, 0)>(vb), h2 = tr_read<v_rd_off(D0, 2, 1)>(vb), l3 = tr_read<v_rd_off(D0, 3, 0)>(vb), h3 = tr_read<v_rd_off(D0, 3, 1)>(vb);
  asm volatile("s_waitcnt lgkmcnt(0)" ::: "memory"); SBAR();
#define PK(L, H) (bf16x8){L[0], L[1], L[2], L[3], H[0], H[1], H[2], H[3]}
  od = __builtin_amdgcn_mfma_f32_32x32x16_bf16(pa0, PK(l0, h0), od, 0, 0, 0);
  od = __builtin_amdgcn_mfma_f32_32x32x16_bf16(pa1, PK(l1, h1), od, 0, 0, 0);
  od = __builtin_amdgcn_mfma_f32_32x32x16_bf16(pa2, PK(l2, h2), od, 0, 0, 0);
  od = __builtin_amdgcn_mfma_f32_32x32x16_bf16(pa3, PK(l3, h3), od, 0, 0, 0);
#undef PK
}
__device__ __forceinline__ void pv_d0(f32x16* o, int vb, bf16x8 pa0, bf16x8 pa1, bf16x8 pa2, bf16x8 pa3) {
  pv_one<0>(o[0], vb, pa0, pa1, pa2, pa3); pv_one<1>(o[1], vb, pa0, pa1, pa2, pa3);
}

__device__ __forceinline__ void attn_unit(const bf16* __restrict__ Qb, const bf16* __restrict__ Kh, const bf16* __restrict__ Vh, bf16* __restrict__ Ob, char* lds) {
  int tid_ = threadIdx.x; asm volatile("" : "+v"(tid_));
  const int tid = tid_, lane = tid & 63, r32 = lane & 31, hi = lane >> 5; const int wid = __builtin_amdgcn_readfirstlane(tid >> 6);
  char* V_lds = lds + LDS_V; char* K_lds = lds + LDS_K;
  float* ws = (float*)(lds + LDS_WS) + wid * 64; float* li_l = ws; float* al_l = ws + 32;
  float m_reg = -1e30f, l_reg = 0; f32x16 o[2] = {}; bf16x8 qr[DQK / 16];
  const bf16* Qw = Qb + (long)(wid * QBLK + r32) * DQK + hi * 8;
#pragma unroll
  for (int d0 = 0; d0 < DQK / 16; ++d0) qr[d0] = *reinterpret_cast<const bf16x8*>(Qw + d0 * 16);
  const bool lowh = wid < 4;
  const int kc0 = tid, kc1 = tid + 512, vc = lowh ? tid + 256 : tid - 256;
  const int kst0 = KSWZ(kc0 / 12, (kc0 % 12) * 16), kst1 = KSWZ(kc1 / 12, (kc1 % 12) * 16), vst = v_st(vc >> 3, (vc & 7) * 8);
  const int vb0 = (int)(uintptr_t)V_lds + v_rd_base(lane);
  struct { bf16x8 k0, k1, v; } sr_[2];
#define SLOAD(i, key0) do { const bf16* kt_ = Kh + (long)(key0) * DQK; const bf16* vt_ = Vh + (long)(key0) * DV; \
    sr_[i].k0 = *reinterpret_cast<const bf16x8*>(kt_ + kc0 * 8); sr_[i].v = *reinterpret_cast<const bf16x8*>(vt_ + vc * 8); \
    if (lowh) sr_[i].k1 = *reinterpret_cast<const bf16x8*>(kt_ + kc1 * 8); } while (0)
#define SWRITE(b, i) do { *(bf16x8*)(K_lds + (b) * SHM_K + kst0) = sr_[i].k0; *(bf16x8*)(V_lds + (b) * SHM_V + vst) = sr_[i].v; \
    if (lowh) *(bf16x8*)(K_lds + (b) * SHM_K + kst1) = sr_[i].k1; } while (0)
#define RESC(a) do { if (__any((a) < 1.f)) { if (hi == 0) al_l[r32] = (a); asm volatile("s_waitcnt lgkmcnt(0)" ::: "memory"); \
    _Pragma("unroll") for (int d = 0; d < 2; ++d) _Pragma("unroll") for (int r = 0; r < 16; ++r) o[d][r] *= al_l[crow(r, hi)]; } } while (0)
  f32x16 pA0, pA1, pB0, pB1; float mnA, mnB, alA, alB; bf16x8 pa0, pa1, pa2, pa3; constexpr int NT = SEQ / KVBLK;
  constexpr int SE = 0, SO = 1;
  SLOAD(SE, 0); SWRITE(0, SE); __syncthreads();
  qkt(pA0, pA1, K_lds, qr, r32, hi); partialSM(pA0, pA1, m_reg, mnA, alA);
  SLOAD(SO, KVBLK); SLOAD(SE, 2 * KVBLK);
  SWRITE(1, SO); __syncthreads();
  for (int j = 1; j + 1 < NT; j += 2) {
    SBAR(); qkt(pB0, pB1, K_lds + SHM_K, qr, r32, hi);
    finishSM(pA0, pA1, alA, l_reg, pa0, pa1, pa2, pa3); SBAR();
    SLOAD(SO, (j + 2) * KVBLK); SBAR();
    pv_d0(o, vb0, pa0, pa1, pa2, pa3); partialSM(pB0, pB1, m_reg, mnB, alB);
    __syncthreads(); SWRITE(0, SE);
    RESC(alB); __syncthreads();
    SBAR(); qkt(pA0, pA1, K_lds, qr, r32, hi);
    finishSM(pB0, pB1, alB, l_reg, pa0, pa1, pa2, pa3); SBAR();
    if (j + 3 < NT) SLOAD(SE, (j + 3) * KVBLK); SBAR();
    pv_d0(o, vb0 + SHM_V, pa0, pa1, pa2, pa3); partialSM(pA0, pA1, m_reg, mnA, alA);
    __syncthreads(); SWRITE(1, SO);
    RESC(alA); __syncthreads();
  }
  SBAR(); qkt(pB0, pB1, K_lds + SHM_K, qr, r32, hi);
  finishSM(pA0, pA1, alA, l_reg, pa0, pa1, pa2, pa3); SBAR();
  pv_d0(o, vb0, pa0, pa1, pa2, pa3); partialSM(pB0, pB1, m_reg, mnB, alB);
  __syncthreads(); RESC(alB);
  finishSM(pB0, pB1, alB, l_reg, pa0, pa1, pa2, pa3); SBAR();
  pv_d0(o, vb0 + SHM_V, pa0, pa1, pa2, pa3);
  if (hi == 0) li_l[r32] = l_reg; asm volatile("s_waitcnt lgkmcnt(0)" ::: "memory");
  float rli[16];
#pragma unroll
  for (int r = 0; r < 16; ++r) rli[r] = __builtin_amdgcn_rcpf(li_l[crow(r, hi)]);
  { bf16* stg = (bf16*)(lds + LDS_OST) + wid * 2048;
#pragma unroll
    for (int r = 0; r < 16; ++r) { const int orow = crow(r, hi);
#pragma unroll
      for (int d0 = 0; d0 < 2; ++d0) stg[orow * 64 + d0 * 32 + r32] = (bf16)(cvtpk(o[d0][r] * rli[r], 0.f) & 0xffffu); }
    asm volatile("s_waitcnt lgkmcnt(0)" ::: "memory");
    bf16* Ow = Ob + (long)(wid * QBLK) * 512;
#pragma unroll
    for (int i = 0; i < 4; ++i) { const int row = i * 8 + (lane >> 3), ch = lane & 7; const u32x4 v = *(const u32x4*)(stg + row * 64 + ch * 8); *(u32x4*)(Ow + (long)row * 512 + ch * 8) = v; } }
  __syncthreads();
#undef SLOAD
#undef SWRITE
#undef RESC
}
#undef KSWZ
#undef SBAR
}


constexpr int NWAVES = 8;
#ifndef MK_PER_PHASE
#define MK_PER_PHASE 0
#endif
constexpr int N_PHASES = 12;
constexpr int BATCH = 8, SEQ = 2048, D = 1024, NH = 8, QL = 256, KVL = 128, CC = 512, CK = 31, DFF = 2816, DIN = 3488, NMOD = 6;
constexpr int M = BATCH * SEQ;
constexpr int NPROJ = 3584;
constexpr float EPS_RMS = 1e-6f, EPS_LN = 1e-5f;

constexpr size_t MiB = 1u << 20;
constexpr size_t WS_CTL = 0, CTL_ZERO_BYTES = 1 * MiB;
constexpr size_t WS_MOD = 512 * 1024;
constexpr size_t WS_ROPE = 2 * MiB;
constexpr size_t WS_WIN = 4 * MiB, WS_WQUP = 11 * MiB, WS_WKVUP = 11 * MiB + 512 * 1024, WS_WAO = 12 * MiB, WS_WCO = 13 * MiB, WS_WOUT = 14 * MiB, WS_WGU = 16 * MiB, WS_WDN = 27 * MiB;
constexpr size_t WS_H = 33 * MiB, WS_QA = 65 * MiB, WS_KVA = 73 * MiB, WS_Z = 81 * MiB, WS_SGA = 97 * MiB, WS_SGB = 129 * MiB, WS_ZC = 161 * MiB, WS_Q = 177 * MiB, WS_K = 201 * MiB, WS_V = 225 * MiB, WS_KR = 241 * MiB;
constexpr size_t WS_AO = WS_Z;
constexpr size_t WS_ACT = WS_SGA;
constexpr size_t WS_END = 242 * MiB;
static_assert(WS_WDN + (size_t)D * DFF * 2 <= WS_H && WS_ACT + (size_t)M * DFF * 2 <= WS_K && WS_KR + (size_t)M * 32 * 2 <= WS_END, "d_ws map");
constexpr int CW_TMO = 0, CW_BAR = 4096;

constexpr int RING_BYTES = 131072, LDSCTL_OFF = RING_BYTES, MISC_OFF = LDSCTL_OFF + 320, LDS_BYTES = 147456;

#define GAS __attribute__((address_space(1)))
#define LAS __attribute__((address_space(3)))
typedef unsigned short bf16;
typedef unsigned v4u __attribute__((ext_vector_type(4)));
typedef float f32x4 __attribute__((ext_vector_type(4)));
typedef short bf16x8 __attribute__((ext_vector_type(8)));
typedef GAS unsigned gu32;
typedef GAS unsigned long long gu64;
#define RLX_AGENT __ATOMIC_RELAXED, __HIP_MEMORY_SCOPE_AGENT
#define LDS_WAIT() asm volatile("s_waitcnt lgkmcnt(0)" ::: "memory")
#define VM_WAIT() asm volatile("s_waitcnt vmcnt(0)" ::: "memory")
__device__ __forceinline__ unsigned long long rt() { return __builtin_amdgcn_s_memrealtime(); }
__device__ __forceinline__ unsigned f2bf(float f) { unsigned u = __builtin_bit_cast(unsigned, f); return (u + 0x7fffu + ((u >> 16) & 1u)) >> 16; }
__device__ __forceinline__ unsigned pk2(float lo, float hi) { return f2bf(lo) | (f2bf(hi) << 16); }
typedef unsigned v2u __attribute__((ext_vector_type(2)));
__device__ __forceinline__ float bf2f(unsigned short h) { return __uint_as_float((unsigned)h << 16); }
__device__ __forceinline__ float sigm_f(float v) { return __builtin_amdgcn_rcpf(1.f + __builtin_amdgcn_exp2f(-1.4426950408889634f * v)); }
__device__ __forceinline__ float wave_sum(float v) {
#pragma unroll
    for (int o = 1; o < 64; o <<= 1) v += __shfl_xor(v, o);
    return v;
}


#define XB_TMO      128
#define XB_XCNT(j)  (256  + 64 * (j))
#define XB_XSUB(j)  (1280 + 64 * (j))
#define XB_XGEN(j)  (2304 + 64 * (j))
#define XB_TOP      3328
#define XB_TOPGEN   3392
#define XCD_BAR_WORDS 3456
#define XB_SPIN_CAP (1u << 18)

__device__ __forceinline__ unsigned xb_ld(unsigned* p)              { return __hip_atomic_load(p, __ATOMIC_RELAXED, __HIP_MEMORY_SCOPE_AGENT); }
__device__ __forceinline__ unsigned xb_add(unsigned* p, unsigned v) { return __hip_atomic_fetch_add(p, v, __ATOMIC_RELAXED, __HIP_MEMORY_SCOPE_AGENT); }
__device__ __forceinline__ unsigned xb_xcc_id() { return (unsigned)__builtin_amdgcn_s_getreg((3 << 11) | 20) & 0xFu; }
#define XB_SPIN(cond, bar) do { unsigned _sp = 0; while (cond) { __builtin_amdgcn_s_sleep(1); \
    if ((++_sp & 255u) == 0u) { if (xb_ld(&(bar)[XB_TMO])) break; if (_sp > XB_SPIN_CAP) { atomicAdd(&(bar)[XB_TMO], 1u); break; } } } } while (0)

struct XcdBarrier {
    unsigned* bar; unsigned x;
    volatile LAS unsigned* st;
};

__device__ __forceinline__ XcdBarrier xcd_barrier_post(unsigned* bar, volatile LAS unsigned* st) {
    XcdBarrier b; b.bar = bar; b.x = xb_xcc_id(); b.st = st;
    if (threadIdx.x == 0) (void)xb_add(&bar[XB_XCNT(b.x)], 1u);
    return b;
}
__device__ __forceinline__ void xcd_barrier_complete(unsigned* bar, unsigned x, unsigned& nloc, unsigned& nx) {
    const unsigned G = gridDim.x * gridDim.y * gridDim.z;
    unsigned sum, cnt, mine, sp = 0u;
    for (;;) {
        sum = 0u; cnt = 0u; mine = 0u;
#pragma unroll
        for (unsigned j = 0; j < 16; ++j) { const unsigned c = xb_ld(&bar[XB_XCNT(j)]); sum += c; cnt += (c > 0u) ? 1u : 0u; mine = (j == x) ? c : mine; }
        if (sum == G) break;
        __builtin_amdgcn_s_sleep(1);
        if ((++sp & 255u) == 0u) { if (xb_ld(&bar[XB_TMO])) break; if (sp > XB_SPIN_CAP) { atomicAdd(&bar[XB_TMO], 1u); break; } }
    }
    nloc = mine > 0u ? mine : 1u; nx = cnt > 0u ? cnt : 1u;
}

__device__ __forceinline__ void xcd_barrier(const XcdBarrier& b) {
    asm volatile("s_waitcnt vmcnt(0)" ::: "memory");
    __syncthreads();
    if (threadIdx.x == 0) {
        unsigned* bar = b.bar;
        __builtin_amdgcn_s_waitcnt(0);
        unsigned nloc = b.st[0], nx = b.st[1];
        if (nloc == 0u) { xcd_barrier_complete(bar, b.x, nloc, nx); b.st[0] = nloc; b.st[1] = nx; }
        const unsigned old = xb_add(&bar[XB_XSUB(b.x)], 1u);
        const unsigned gen = old / nloc;
        if (old + 1u == (gen + 1u) * nloc) {
            __builtin_amdgcn_fence(__ATOMIC_RELEASE, "agent");
            asm volatile("s_waitcnt vmcnt(0)" ::: "memory");
            const unsigned og = xb_add(&bar[XB_TOP], 1u);
            const unsigned tg = og / nx;
            if (og + 1u == (tg + 1u) * nx) xb_add(&bar[XB_TOPGEN], 1u);
            else XB_SPIN(xb_ld(&bar[XB_TOPGEN]) == tg, bar);
            __builtin_amdgcn_fence(__ATOMIC_ACQUIRE, "agent");
            xb_add(&bar[XB_XGEN(b.x)], 1u);
            asm volatile("s_waitcnt vmcnt(0)" ::: "memory");
        } else {
            XB_SPIN(xb_ld(&bar[XB_XGEN(b.x)]) == gen, bar);
            __builtin_amdgcn_fence(__ATOMIC_ACQUIRE, "agent");
            asm volatile("s_waitcnt vmcnt(0)" ::: "memory");
        }
    }
    __syncthreads();
}


struct Args { const void* in[23]; float* out; unsigned char* ws; int ph_lo, ph_hi; };
struct Frame { unsigned char* lds; int tid, lane, wave, vcu, G; };
#define IN_F(k) ((const float*)args.in[k])
enum { I_X = 0, I_C = 1, I_POS = 2, I_WADA = 3, I_BADA = 4, I_GMIX = 5, I_WIN = 6, I_GQA = 7, I_WQUP = 8, I_GKVA = 9, I_WKVUP = 10, I_WAO = 11, I_WDW = 12, I_BDW = 13, I_GCLN = 14, I_BCLN = 15,
       I_WCO = 16, I_WOUT = 17, I_GFFN = 18, I_WFG = 19, I_WFU = 20, I_WFD = 21, I_GFIN = 22 };

__device__ __forceinline__ void transpose_item(const float* W, int ldw, int k0, int n0, bf16* WT, int ldt, int dst_row0, float* scr, int lane) {
#pragma unroll 8
    for (int i = 0; i < 32; ++i) { const int kk = 2 * i + (lane >> 5); scr[kk * 33 + (lane & 31)] = W[(size_t)(k0 + kk) * ldw + n0 + (lane & 31)]; }
    LDS_WAIT(); asm volatile("" ::: "memory");
    const int c = lane & 7;
#pragma unroll
    for (int j = 0; j < 4; ++j) { const int n = (lane >> 3) + 8 * j; const float* s = scr + (8 * c) * 33 + n;
        v4u o; o.x = pk2(s[0 * 33], s[1 * 33]); o.y = pk2(s[2 * 33], s[3 * 33]); o.z = pk2(s[4 * 33], s[5 * 33]); o.w = pk2(s[6 * 33], s[7 * 33]);
        *(v4u*)(WT + (size_t)(dst_row0 + n) * ldt + k0 + 8 * c) = o; }
    LDS_WAIT(); asm volatile("" ::: "memory");
}
__device__ __forceinline__ int map_win(int n0) {
    if (n0 < 416) return n0;
    if (n0 < 928) { const int o = n0 - 416; return 512 + 256 * (o >> 7) + (o & 127); }
    if (n0 < 1440) { const int o = n0 - 928; return 512 + 256 * (o >> 7) + 128 + (o & 127); }
    return n0 - 1440 + 1536;
}
__device__ __forceinline__ void rope_angle(int pos, int i, float& cs, float& sn) {
    float f = 1.0f;
    if (i == 1) f = 0.5623413251903491f; if (i == 2) f = 0.31622776601683794f; if (i == 3) f = 0.1778279410038923f; if (i == 4) f = 0.1f;
    if (i == 5) f = 0.05623413251903491f; if (i == 6) f = 0.03162277660168379f; if (i == 7) f = 0.01778279410038923f; if (i == 8) f = 0.01f;
    if (i == 9) f = 0.005623413251903491f; if (i == 10) f = 0.0031622776601683794f; if (i == 11) f = 0.0017782794100389228f; if (i == 12) f = 0.001f;
    if (i == 13) f = 0.0005623413251903491f; if (i == 14) f = 0.00031622776601683794f; if (i == 15) f = 0.00017782794100389227f;
    const float ang = (float)pos * f;
    const double a = (double)ang, kq = rint(a * 0.15915494309189535);
    const float r = (float)(a - kq * 6.283185307179586);
    cs = cosf(r); sn = sinf(r);
}

__device__ __forceinline__ void p0_prologue(const Frame& F, const Args& args) {
    float* scr = (float*)(F.lds + F.wave * 16384);
    const int gw = F.vcu * NWAVES + F.wave, NGW = F.G * NWAVES;
    unsigned char* ws = args.ws;
    constexpr int I_IN = 16 * 109, I_QUP = 4 * 24, I_KVUP = 2 * 32, I_AO = 8 * 32, I_CO = 8 * 32, I_OUT = 16 * 32, I_G = 16 * 88, I_U = 16 * 88, I_DN = 44 * 32;
    constexpr int NITEMS = I_IN + I_QUP + I_KVUP + I_AO + I_CO + I_OUT + I_G + I_U + I_DN;
    for (int it = gw; it < NITEMS; it += NGW) {
        int r = it;
        if (r < I_IN) { const int kb = r / 109, nb = r % 109; transpose_item(IN_F(I_WIN), DIN, 64 * kb, 32 * nb, (bf16*)(ws + WS_WIN), D, map_win(32 * nb), scr, F.lane); continue; } r -= I_IN;
        if (r < I_QUP) { const int kb = r / 24, nb = r % 24; transpose_item(IN_F(I_WQUP), 768, 64 * kb, 32 * nb, (bf16*)(ws + WS_WQUP), 256, 32 * nb, scr, F.lane); continue; } r -= I_QUP;
        if (r < I_KVUP) { const int kb = r / 32, nb = r % 32; transpose_item(IN_F(I_WKVUP), 1024, 64 * kb, 32 * nb, (bf16*)(ws + WS_WKVUP), 256, 32 * nb, scr, F.lane); continue; } r -= I_KVUP;
        if (r < I_AO) { const int kb = r / 32, nb = r % 32; transpose_item(IN_F(I_WAO), 1024, 64 * kb, 32 * nb, (bf16*)(ws + WS_WAO), 512, 32 * nb, scr, F.lane); continue; } r -= I_AO;
        if (r < I_CO) { const int kb = r / 32, nb = r % 32; transpose_item(IN_F(I_WCO), 1024, 64 * kb, 32 * nb, (bf16*)(ws + WS_WCO), 512, 32 * nb, scr, F.lane); continue; } r -= I_CO;
        if (r < I_OUT) { const int kb = r / 32, nb = r % 32; transpose_item(IN_F(I_WOUT), 1024, 64 * kb, 32 * nb, (bf16*)(ws + WS_WOUT), 1024, 32 * nb, scr, F.lane); continue; } r -= I_OUT;
        if (r < I_G) { const int kb = r / 88, nb = r % 88, n0 = 32 * nb; transpose_item(IN_F(I_WFG), DFF, 64 * kb, n0, (bf16*)(ws + WS_WGU), 1024, 256 * (n0 >> 7) + (n0 & 127), scr, F.lane); continue; } r -= I_G;
        if (r < I_U) { const int kb = r / 88, nb = r % 88, n0 = 32 * nb; transpose_item(IN_F(I_WFU), DFF, 64 * kb, n0, (bf16*)(ws + WS_WGU), 1024, 256 * (n0 >> 7) + 128 + (n0 & 127), scr, F.lane); continue; } r -= I_U;
        { const int kb = r / 32, nb = r % 32; transpose_item(IN_F(I_WFD), 1024, 64 * kb, 32 * nb, (bf16*)(ws + WS_WDN), DFF, 32 * nb, scr, F.lane); }
    }
    { const int gt = F.vcu * (NWAVES * 64) + F.tid, NGT = F.G * NWAVES * 64; const v4u z = (v4u){0u, 0u, 0u, 0u};
      for (int i = gt; i < 12288 + 16384; i += NGT) {
          if (i < 12288) *(v4u*)(ws + WS_WIN + (size_t)416 * 2048 + (size_t)i * 16) = z;
          else { const int j = i - 12288; *(v4u*)(ws + WS_WKVUP + (size_t)(j >> 4) * 512 + 256 + (j & 15) * 16) = z; } }
      float* RC = (float*)(ws + WS_ROPE); float* RS = RC + (size_t)M * 16;
      for (int i = gt; i < M * 16; i += NGT) { float cs, sn; rope_angle(((const int*)args.in[I_POS])[i >> 4], i & 15, cs, sn); RC[i] = cs; RS[i] = sn; } }
    for (int it = gw; it < 96 * 16; it += NGW) {
        const int cg = it % 96, kc = it / 96, j = 64 * cg + F.lane, k0 = 64 * kc;
        float ca[8];
#pragma unroll
        for (int b = 0; b < 8; ++b) { const float cv = IN_F(I_C)[b * D + k0 + F.lane]; ca[b] = cv * sigm_f(cv); }
        float acc[8];
#pragma unroll
        for (int b = 0; b < 8; ++b) acc[b] = (kc == 0) ? IN_F(I_BADA)[j] : 0.f;
#pragma unroll 16
        for (int kk = 0; kk < 64; ++kk) { const float w = IN_F(I_WADA)[(size_t)(k0 + kk) * (NMOD * D) + j];
#pragma unroll
            for (int b = 0; b < 8; ++b) acc[b] += __shfl(ca[b], kk) * w; }
        float* mod = (float*)(ws + WS_MOD);
#pragma unroll
        for (int b = 0; b < 8; ++b) atomicAdd(mod + b * (NMOD * D) + j, acc[b]);
    }
}

__device__ __forceinline__ void rows_rms_mod(const Frame& F, const Args& args, const float* src, const float* g, int shift_chunk, int scale_chunk, bf16* dst) {
    for (int gw = F.vcu * NWAVES + F.wave; gw < M / 8; gw += F.G * NWAVES) {
    const int b = (gw * 8) >> 11; const float* mod = (const float*)(args.ws + WS_MOD) + (size_t)b * (NMOD * D);
    f32x4 gs[4], sh[4];
#pragma unroll
    for (int j = 0; j < 4; ++j) { const int c = 4 * F.lane + 256 * j; const f32x4 gg = *(const f32x4*)(g + c), sc = *(const f32x4*)(mod + scale_chunk * D + c); gs[j] = gg * (sc + 1.0f); sh[j] = *(const f32x4*)(mod + shift_chunk * D + c); }
    for (int rr = 0; rr < 8; ++rr) { const size_t row = (size_t)gw * 8 + rr;
        const f32x4* xr = (const f32x4*)(src + row * D) + F.lane; f32x4 v[4]; float s = 0.f;
#pragma unroll
        for (int j = 0; j < 4; ++j) { v[j] = xr[64 * j]; s += (v[j].x * v[j].x + v[j].y * v[j].y) + (v[j].z * v[j].z + v[j].w * v[j].w); }
        const float rstd = rsqrtf(wave_sum(s) * (1.f / D) + EPS_RMS);
        unsigned long long* o8 = (unsigned long long*)(dst + row * D) + F.lane;
#pragma unroll
        for (int j = 0; j < 4; ++j) { const f32x4 y = v[j] * rstd * gs[j] + sh[j]; o8[64 * j] = (unsigned long long)pk2(y.x, y.y) | ((unsigned long long)pk2(y.z, y.w) << 32); } }
    }
}

__device__ __forceinline__ void p3_rows_and_conv(const Frame& F, const Args& args) {
    unsigned char* ws = args.ws;
    bf16* QA = (bf16*)(ws + WS_QA); bf16* KVA = (bf16*)(ws + WS_KVA); const bf16* KR = (const bf16*)(ws + WS_KR); bf16* Kb = (bf16*)(ws + WS_K);
    const float* RC = (const float*)(ws + WS_ROPE); const float* RS = RC + (size_t)M * 16;
    { const int l = F.lane;
      const f32x4 gq = *(const f32x4*)(IN_F(I_GQA) + 4 * l); const float gk0 = IN_F(I_GKVA)[2 * l], gk1 = IN_F(I_GKVA)[2 * l + 1];
      for (int gw = F.vcu * NWAVES + F.wave; gw < M / 8; gw += F.G * NWAVES)
      for (int rr = 0; rr < 8; ++rr) { const size_t row = (size_t)gw * 8 + rr;
          v2u* qp = (v2u*)(QA + row * 256) + l; const v2u qw = *qp;
          const float q0 = __uint_as_float(qw.x << 16), q1 = __uint_as_float(qw.x & 0xffff0000u), q2 = __uint_as_float(qw.y << 16), q3 = __uint_as_float(qw.y & 0xffff0000u);
          const float rq = rsqrtf(wave_sum((q0 * q0 + q1 * q1) + (q2 * q2 + q3 * q3)) * (1.f / QL) + EPS_RMS);
          *qp = (v2u){pk2(q0 * rq * gq.x, q1 * rq * gq.y), pk2(q2 * rq * gq.z, q3 * rq * gq.w)};
          unsigned* kp = (unsigned*)(KVA + row * 256) + l; const unsigned kw = *kp;
          const float k0 = __uint_as_float(kw << 16), k1 = __uint_as_float(kw & 0xffff0000u);
          const float rk = rsqrtf(wave_sum(k0 * k0 + k1 * k1) * (1.f / KVL) + EPS_RMS);
          *kp = pk2(k0 * rk * gk0, k1 * rk * gk1);
          if (l < 16) { const float x1 = bf2f(KR[row * 32 + l]), x2 = bf2f(KR[row * 32 + 16 + l]); const float cs = RC[row * 16 + l], sn = RS[row * 16 + l];
              const unsigned short o1 = (unsigned short)f2bf(x1 * cs - x2 * sn), o2 = (unsigned short)f2bf(x2 * cs + x1 * sn);
              const int b = (int)(row >> 11), s = (int)(row & 2047);
#pragma unroll
              for (int h = 0; h < 8; ++h) { bf16* kd = Kb + ((size_t)(b * 8 + h) * 2048 + s) * 96 + 64; kd[l] = o1; kd[16 + l] = o2; } } } }
    __syncthreads();
    { const bf16* Z = (const bf16*)(ws + WS_Z); bf16* ZC = (bf16*)(ws + WS_ZC); float* tile = (float*)F.lds;
      const int c = F.tid;
      float wv[CK];
#pragma unroll
      for (int j = 0; j < CK; ++j) wv[j] = IN_F(I_WDW)[j * CC + c];
      const float bias = IN_F(I_BDW)[c];
      float lg[8], lb[8];
#pragma unroll
      for (int i = 0; i < 8; ++i) { lg[i] = IN_F(I_GCLN)[8 * F.lane + i]; lb[i] = IN_F(I_BCLN)[8 * F.lane + i]; }
      for (int run = F.vcu; run < M / 32; run += F.G) {
          const int b = run >> 6, t0 = (run & 63) * 32;
          float v[62];
#pragma unroll
          for (int i = 0; i < 62; ++i) { const int tt = t0 - 15 + i; v[i] = (tt >= 0 && tt < SEQ) ? bf2f(Z[((size_t)b * SEQ + tt) * CC + c]) : 0.f; }
#pragma unroll
          for (int t = 0; t < 32; ++t) { float a = bias;
#pragma unroll
              for (int j = 0; j < CK; ++j) a += v[t + j] * wv[j];
              tile[t * CC + c] = a; }
          __syncthreads();
#pragma unroll
          for (int q = 0; q < 4; ++q) { const int t = F.wave * 4 + q; const f32x4 a0 = *(const f32x4*)(tile + t * CC + 8 * F.lane), a1 = *(const f32x4*)(tile + t * CC + 8 * F.lane + 4);
              const float mean = wave_sum((a0.x + a0.y) + (a0.z + a0.w) + (a1.x + a1.y) + (a1.z + a1.w)) * (1.f / CC);
              const f32x4 d0 = a0 - mean, d1 = a1 - mean;
              const float var = wave_sum((d0.x * d0.x + d0.y * d0.y) + (d0.z * d0.z + d0.w * d0.w) + (d1.x * d1.x + d1.y * d1.y) + (d1.z * d1.z + d1.w * d1.w)) * (1.f / CC);
              const float rstd = rsqrtf(var + EPS_LN);
              float y[8];
#pragma unroll
              for (int i = 0; i < 4; ++i) { y[i] = d0[i] * rstd * lg[i] + lb[i]; y[4 + i] = d1[i] * rstd * lg[4 + i] + lb[4 + i]; }
#pragma unroll
              for (int i = 0; i < 8; ++i) y[i] = y[i] * sigm_f(y[i]);
              *(v4u*)(ZC + ((size_t)b * SEQ + t0 + t) * CC + 8 * F.lane) = (v4u){pk2(y[0], y[1]), pk2(y[2], y[3]), pk2(y[4], y[5]), pk2(y[6], y[7])}; }
          __syncthreads();
      } }
}

__device__ __forceinline__ void p11_final(const Frame& F, const Args& args) {
    f32x4 gs[4];
#pragma unroll
    for (int j = 0; j < 4; ++j) gs[j] = *(const f32x4*)(IN_F(I_GFIN) + 4 * F.lane + 256 * j);
    for (int gw = F.vcu * NWAVES + F.wave; gw < M / 8; gw += F.G * NWAVES)
    for (int rr = 0; rr < 8; ++rr) { const size_t row = (size_t)gw * 8 + rr;
        f32x4* xr = (f32x4*)(args.out + row * D) + F.lane; f32x4 v[4]; float s = 0.f;
#pragma unroll
        for (int j = 0; j < 4; ++j) { v[j] = xr[64 * j]; s += (v[j].x * v[j].x + v[j].y * v[j].y) + (v[j].z * v[j].z + v[j].w * v[j].w); }
        const float rstd = rsqrtf(wave_sum(s) * (1.f / D) + EPS_RMS);
#pragma unroll
        for (int j = 0; j < 4; ++j) xr[64 * j] = v[j] * rstd * gs[j]; }
}

__global__ void __launch_bounds__(NWAVES * 64, 2) mk_fwd(Args args) {
    extern __shared__ __attribute__((aligned(16))) unsigned char lds[];
    Frame F;
    F.lds = lds; F.tid = threadIdx.x; F.lane = F.tid & 63; F.wave = __builtin_amdgcn_readfirstlane(F.tid >> 6);
    F.G = gridDim.x; { const int bx = blockIdx.x; F.vcu = (F.G % 8 == 0) ? (bx % 8) * (F.G / 8) + bx / 8 : bx; }
    unsigned char* ws = args.ws;
    gu32* ctl = (gu32*)(ws + WS_CTL);
    volatile LAS unsigned* MISC = (volatile LAS unsigned*)((LAS unsigned char*)lds + MISC_OFF);
    for (int u = F.tid; u < (LDS_BYTES - LDSCTL_OFF) / 4; u += NWAVES * 64) ((LAS unsigned*)((LAS unsigned char*)lds + LDSCTL_OFF))[u] = 0u;
    __syncthreads();
    XcdBarrier bar; bar.bar = (unsigned*)(ctl + CW_BAR); bar.x = 0; bar.st = nullptr;
    if (!MK_PER_PHASE) bar = xcd_barrier_post((unsigned*)(ctl + CW_BAR), MISC + 8);
    const int lo = args.ph_lo, hi = args.ph_hi;
#ifndef PH_MASK
#define PH_MASK 0xFFF
#endif
#define IN(k) (((PH_MASK >> (k)) & 1) && lo <= (k) && (k) < hi)
#define SEAM(k) do { if (IN(k) && IN((k) + 1)) xcd_barrier(bar); REFRESH(); } while (0)
#define REFRESH() do { int t_ = threadIdx.x; asm volatile("" : "+v"(t_)); F.tid = t_; F.lane = t_ & 63; F.wave = __builtin_amdgcn_readfirstlane(t_ >> 6); } while (0)
    LAS unsigned char* ring = (LAS unsigned char*)lds;
    bf16* H = (bf16*)(ws + WS_H);
    const float* MOD = (const float*)(ws + WS_MOD);

    if (IN(0)) { p0_prologue(F, args); } SEAM(0);
    if (IN(1)) { rows_rms_mod(F, args, IN_F(I_X), IN_F(I_GMIX), 0, 1, H); } SEAM(1);
    if (IN(2)) {
        pg8::Gemm g{H, (const bf16*)(ws + WS_WIN), M, NPROJ, D}; pg8::StaticOrder S; S.init(M, NPROJ, F.G, (int)blockIdx.x);
        pg8::EpiProj E{(bf16*)(ws + WS_QA), (bf16*)(ws + WS_KVA), (bf16*)(ws + WS_KR), (bf16*)(ws + WS_Z), (bf16*)(ws + WS_SGA), (bf16*)(ws + WS_SGB)};
        pg8::gemm_phase<pg8::EpiProj, pg8::StaticOrder, true, true>(ring, g, S, E);
    } SEAM(2);
    if (IN(3)) { p3_rows_and_conv(F, args); } SEAM(3);
    if (IN(4)) {
#ifndef P4_MASK
#define P4_MASK 7
#endif
        int K256 = 256; asm volatile("" : "+s"(K256));
        if (P4_MASK & 1) { pg8::Gemm g{(const bf16*)(ws + WS_QA), (const bf16*)(ws + WS_WQUP), M, 768, K256}; pg8::StaticOrder S; S.init(M, 768, F.G, (int)blockIdx.x);
          pg8::EpiQup E{(bf16*)(ws + WS_Q), (const float*)(ws + WS_ROPE), (const float*)(ws + WS_ROPE) + (size_t)M * 16};
          pg8::gemm_phase<pg8::EpiQup, pg8::StaticOrder, true, true>(ring, g, S, E); }
        if (P4_MASK & 2) { pg8::Gemm g{(const bf16*)(ws + WS_KVA), (const bf16*)(ws + WS_WKVUP), M, 1024, K256}; pg8::StaticOrder S; S.init(M, 1024, F.G, (int)blockIdx.x);
          pg8::EpiKVup E{(bf16*)(ws + WS_K), (bf16*)(ws + WS_V)};
          pg8::gemm_phase<pg8::EpiKVup, pg8::StaticOrder, true, true>(ring, g, S, E); }
        if (P4_MASK & 4) { pg8::Gemm g{(const bf16*)(ws + WS_ZC), (const bf16*)(ws + WS_WCO), M, 1024, 512}; pg8::StaticOrder S; S.init(M, 1024, F.G, (int)blockIdx.x);
          pg8::EpiMulGate E{(bf16*)(ws + WS_SGB)};
          pg8::gemm_phase<pg8::EpiMulGate, pg8::StaticOrder, true, true>(ring, g, S, E); }
    } SEAM(4);
    if (IN(5)) {
        const att::bf16* Q = (const att::bf16*)(ws + WS_Q); const att::bf16* K = (const att::bf16*)(ws + WS_K); const att::bf16* V = (const att::bf16*)(ws + WS_V); att::bf16* AO = (att::bf16*)(ws + WS_AO);
        for (int unit = F.vcu * 2; unit < 512; unit = (unit & 1) ? unit + 2 * F.G - 1 : unit + 1) {
            const int bh = unit >> 3, qb = unit & 7, b = bh >> 3, h = bh & 7;
            att::attn_unit(Q + ((size_t)bh * SEQ + qb * 256) * 96, K + (size_t)bh * SEQ * 96, V + (size_t)bh * SEQ * 64, AO + ((size_t)b * SEQ + qb * 256) * 512 + h * 64, (char*)lds); }
    } SEAM(5);
    if (IN(6)) {
        pg8::Gemm g{(const bf16*)(ws + WS_AO), (const bf16*)(ws + WS_WAO), M, 1024, 512}; pg8::StaticOrder S; S.init(M, 1024, F.G, (int)blockIdx.x);
        pg8::EpiMerge E{(bf16*)(ws + WS_SGA), (const bf16*)(ws + WS_SGB)};
        pg8::gemm_phase<pg8::EpiMerge, pg8::StaticOrder, true, true>(ring, g, S, E);
    } SEAM(6);
    if (IN(7)) {
        pg8::Gemm g{(const bf16*)(ws + WS_SGA), (const bf16*)(ws + WS_WOUT), M, 1024, 1024}; pg8::StaticOrder S; S.init(M, 1024, F.G, (int)blockIdx.x);
        pg8::EpiResid E{IN_F(I_X), args.out, MOD + 2 * D};
        pg8::gemm_phase<pg8::EpiResid, pg8::StaticOrder, true, true>(ring, g, S, E);
    } SEAM(7);
    if (IN(8)) { rows_rms_mod(F, args, args.out, IN_F(I_GFFN), 3, 4, H); } SEAM(8);
    if (IN(9)) {
        pg8::Gemm g{H, (const bf16*)(ws + WS_WGU), M, 2 * DFF, D}; pg8::StaticOrder S; S.init(M, 2 * DFF, F.G, (int)blockIdx.x);
        pg8::EpiSwiGLU E{(bf16*)(ws + WS_ACT)};
        pg8::gemm_phase<pg8::EpiSwiGLU, pg8::StaticOrder, true, true>(ring, g, S, E);
    } SEAM(9);
    if (IN(10)) {
        pg8::Gemm g{(const bf16*)(ws + WS_ACT), (const bf16*)(ws + WS_WDN), M, 1024, DFF}; pg8::StaticOrder S; S.init(M, 1024, F.G, (int)blockIdx.x);
        pg8::EpiResid E{args.out, args.out, MOD + 5 * D};
        pg8::gemm_phase<pg8::EpiResid, pg8::StaticOrder, true, true>(ring, g, S, E);
    } SEAM(10);
    if (IN(11)) { p11_final(F, args); }
#undef IN
#undef SEAM
}

#ifdef MK_PROBE_AFTER
__global__ void __launch_bounds__(256) dump_bf16(const unsigned short* src, float* out, size_t n) {
    for (size_t i = (size_t)blockIdx.x * 256 + threadIdx.x; i < (size_t)M * D; i += (size_t)gridDim.x * 256) out[i] = i < n ? __uint_as_float((unsigned)src[i] << 16) : 0.f;
}
#endif
extern "C" void kernel_launch(void* const* d_in, const int* in_sizes, int n_in, void* d_out, int out_size, void* d_ws, size_t ws_size, hipStream_t stream) {
    static int grid = 0;
    if (grid == 0) {
        if (n_in != 23 || out_size != M * D || ws_size < WS_END) { fprintf(stderr, "kernel_launch: unexpected shapes: n_in %d out %d ws %zu\n", n_in, out_size, ws_size); grid = -1; return; }
        int dev = 0, cus = 0, per_cu = 0;
        if (hipGetDevice(&dev) != hipSuccess || hipDeviceGetAttribute(&cus, hipDeviceAttributeMultiprocessorCount, dev) != hipSuccess) { grid = -1; return; }
        if (hipFuncSetAttribute((const void*)mk_fwd, hipFuncAttributeMaxDynamicSharedMemorySize, LDS_BYTES) != hipSuccess) { fprintf(stderr, "kernel_launch: hipFuncSetAttribute failed\n"); grid = -1; return; }
        if (hipOccupancyMaxActiveBlocksPerMultiprocessor(&per_cu, (const void*)mk_fwd, NWAVES * 64, LDS_BYTES) != hipSuccess || per_cu < 1) fprintf(stderr, "kernel_launch: occupancy query says %d\n", per_cu);
        (void)hipGetLastError();
        grid = cus;
        if (grid != 256) fprintf(stderr, "kernel_launch: %d CUs (built for 256)\n", grid);
    }
    if (grid < 0) return;
    if (hipMemsetAsync((char*)d_ws + WS_CTL, 0, CTL_ZERO_BYTES, stream) != hipSuccess) { fprintf(stderr, "kernel_launch: memset failed\n"); return; }
    Args a{};
    for (int i = 0; i < 23; ++i) a.in[i] = d_in[i];
    a.out = (float*)d_out; a.ws = (unsigned char*)d_ws;
#if MK_PER_PHASE
#ifdef MK_PROBE_AFTER
    for (int p = 0; p <= MK_PROBE_AFTER; ++p) { a.ph_lo = p; a.ph_hi = p + 1; hipLaunchKernelGGL(mk_fwd, dim3(grid), dim3(NWAVES * 64), LDS_BYTES, stream, a); }
    hipLaunchKernelGGL(dump_bf16, dim3(4096), dim3(256), 0, stream, (const unsigned short*)((const char*)d_ws + MK_PROBE_OFF), (float*)d_out, (size_t)MK_PROBE_N);
#else
    for (int p = 0; p < N_PHASES; ++p) { a.ph_lo = p; a.ph_hi = p + 1; hipLaunchKernelGGL(mk_fwd, dim3(grid), dim3(NWAVES * 64), LDS_BYTES, stream, a); }
#endif
#else
    a.ph_lo = 0; a.ph_hi = N_PHASES; hipLaunchKernelGGL(mk_fwd, dim3(grid), dim3(NWAVES * 64), LDS_BYTES, stream, a);
#endif
    const hipError_t le = hipPeekAtLastError();
    if (le != hipSuccess) fprintf(stderr, "kernel_launch: launch failed: %s\n", hipGetErrorName(le));
}
```
